# Optimizing an MI355X kernel written in HIP

```python
import math
import jax
import jax.numpy as jnp
from jax import lax
import numpy as np

D_MODEL = 1024
BATCH = 1
SEQ = 16384
DEPTH = 2
DEC_BATCH = 32
DEC_SEQ = 2048
PAST_LEN = 128

N_META = 16
BLOCK = 128
NORM_EPS = 1e-6
NEG = -1e30
D_FF = 2816
RW_HEADS = 4
RW_HEAD_DIM = 64
RW_WIDTH = RW_HEADS * RW_HEAD_DIM
RW_DECAY_RANK = 64
RW_A_RANK = 64
RW_GATE_RANK = 128
RW_GN_EPS = 64e-5
SWA_Q_HEADS = 8
SWA_KV_HEADS = 2
SWA_GROUP = SWA_Q_HEADS // SWA_KV_HEADS
SWA_HEAD_DIM = 64
SWA_WIDTH = SWA_Q_HEADS * SWA_HEAD_DIM
WINDOW = 128
MLA_HEADS = 4
MLA_Q_RANK = 256
MLA_KV_RANK = 128
MLA_NOPE_DIM = 64
MLA_ROPE_DIM = 32
MLA_QK_DIM = MLA_NOPE_DIM + MLA_ROPE_DIM
MLA_V_DIM = 64
MLA_WIDTH = MLA_HEADS * MLA_V_DIM
ROPE_THETA = 10000.0
REL_BUCKETS = 32
REL_MAX_DIST = 128

MIX_WIDTH = RW_WIDTH + SWA_WIDTH + MLA_WIDTH
RW_COLS = 3 * RW_WIDTH + RW_DECAY_RANK + RW_A_RANK + RW_GATE_RANK
SWA_COLS = (SWA_Q_HEADS + 2 * SWA_KV_HEADS) * SWA_HEAD_DIM
MLA_COLS = MLA_Q_RANK + MLA_KV_RANK + MLA_ROPE_DIM
IN_COLS = RW_COLS + SWA_COLS + MLA_COLS

kernel_name = 'hybrid_bidir_encoder_rwkv7_swa_mla'


def rmsnorm(x, g):
    xf = x.astype(jnp.float32)
    y = xf * lax.rsqrt(jnp.mean(xf * xf, -1, keepdims=True) + NORM_EPS)
    return (y * g.astype(jnp.float32)).astype(x.dtype)


def swiglu(x, wg, wu, wd):
    return (jax.nn.silu(x @ wg) * (x @ wu)) @ wd


def centred_shift(p):
    prev = jnp.pad(p[:, :-1], ((0, 0), (1, 0), (0, 0)))
    nxt = jnp.pad(p[:, 1:], ((0, 0), (0, 1), (0, 0)))
    return 0.5 * (prev + nxt)


def rwkv7_scan(r, w, k, v, kk, a):
    B, T, H, N = r.shape
    xs = tuple(jnp.moveaxis(t, 1, 0) for t in (r, w, k, v, kk, a))

    def step(S, inp):
        r_t, w_t, k_t, v_t, kk_t, a_t = inp
        sa = jnp.einsum('bhij,bhj->bhi', S, -kk_t)
        S = (S * w_t[:, :, None, :] + sa[..., None] * (kk_t * a_t)[:, :, None, :]
             + v_t[..., None] * k_t[:, :, None, :])
        return S, jnp.einsum('bhij,bhj->bhi', S, r_t)

    _, y = lax.scan(step, jnp.zeros((B, H, N, N), jnp.float32), xs)
    return jnp.moveaxis(y, 0, 1)


def rwkv7_mixer(p, mu, w0, w2, a0, a2, g2, k_k, k_a, r_k, ln_g, ln_b):
    B, T, _ = p.shape
    dt = p.dtype
    p = (p + mu * (centred_shift(p) - p)).astype(jnp.float32)
    splits = [RW_WIDTH, 2 * RW_WIDTH, 3 * RW_WIDTH, 3 * RW_WIDTH + RW_DECAY_RANK,
              3 * RW_WIDTH + RW_DECAY_RANK + RW_A_RANK]
    r, k, v, w_lo, a_lo, g_lo = jnp.split(p, splits, -1)
    heads = lambda t: t.reshape(B, T, RW_HEADS, RW_HEAD_DIM)
    g = jax.nn.sigmoid(g_lo) @ g2
    w_lo = jnp.tanh(w_lo)
    kk = heads(k * k_k)
    kk = kk / jnp.maximum(jnp.sqrt(jnp.sum(kk * kk, -1, keepdims=True)), 1e-12)
    rh, kh, vh = heads(r), heads(k), heads(v)
    outs = []
    for d in range(2):
        w_raw = w0[d] + w_lo @ w2[d]
        decay = jnp.exp(-jnp.exp(-jax.nn.softplus(-w_raw) - 0.5))
        a = jax.nn.sigmoid(a0[d] + a_lo @ a2[d])
        kd = k * (1.0 + (a - 1.0) * k_a)
        ins = (rh, heads(decay), heads(kd), vh, kk, heads(a))
        if d == 1:
            ins = tuple(jnp.flip(t, 1) for t in ins)
        yd = rwkv7_scan(*ins)
        if d == 1:
            yd = jnp.flip(yd, 1)
        outs.append(yd)
    y = outs[0] + outs[1]
    mean = jnp.mean(y, -1, keepdims=True)
    var = jnp.mean(jnp.square(y - mean), -1, keepdims=True)
    y = ((y - mean) * lax.rsqrt(var + RW_GN_EPS)).reshape(B, T, RW_WIDTH) * ln_g + ln_b
    bonus = jnp.sum(rh * kh * r_k, -1, keepdims=True) * vh
    y = (y + bonus.reshape(B, T, RW_WIDTH)) * g
    return y.astype(dt)


def t5_bucket(rel):
    nb = REL_BUCKETS // 2
    max_exact = nb // 2
    n = jnp.abs(rel)
    large = max_exact + (jnp.log(jnp.maximum(n, 1).astype(jnp.float32) / max_exact)
                         / math.log(REL_MAX_DIST / max_exact) * (nb - max_exact)).astype(jnp.int32)
    large = jnp.minimum(large, nb - 1)
    return jnp.where(rel > 0, nb, 0) + jnp.where(n < max_exact, n, large)


def band_softmax(q, k_m, v_m, k_b, v_b, bias_m, bias_b, valid_b, sink):
    s_m = jnp.einsum('...qhgd,...khd->...hgqk', q, k_m) + bias_m
    s_b = jnp.where(valid_b, jnp.einsum('...qhgd,...khd->...hgqk', q, k_b) + bias_b, NEG)
    s_sink = jnp.broadcast_to(sink[:, :, None, None], s_m.shape[:-1] + (1,))
    prob = jax.nn.softmax(jnp.concatenate([s_m, s_b, s_sink], -1), -1)
    M = k_m.shape[-3]
    K = k_b.shape[-3]
    return (jnp.einsum('...hgqk,...khd->...qhgd', prob[..., :M], v_m)
            + jnp.einsum('...hgqk,...khd->...qhgd', prob[..., M:M + K], v_b))


def swa_mixer(p, q_norm, k_norm, sink, rel_bias):
    B, T, _ = p.shape
    L = T - N_META
    nb = L // BLOCK
    Hk, G, d = SWA_KV_HEADS, SWA_GROUP, SWA_HEAD_DIM
    q, k, v = jnp.split(p, [SWA_Q_HEADS * d, (SWA_Q_HEADS + Hk) * d], -1)
    q = rmsnorm(q.reshape(B, T, Hk, G, d), q_norm).astype(jnp.float32) * d ** -0.5
    k = rmsnorm(k.reshape(B, T, Hk, d), k_norm).astype(jnp.float32)
    v = v.reshape(B, T, Hk, d).astype(jnp.float32)
    sink = sink.astype(jnp.float32).reshape(Hk, G)
    tab = rel_bias.astype(jnp.float32).reshape(REL_BUCKETS, Hk, G)
    k_m, v_m = k[:, :N_META], v[:, :N_META]
    k_r, v_r = k[:, N_META:], v[:, N_META:]
    pq = jnp.arange(N_META)
    rel_mm = pq[None, :] - pq[:, None]
    rel_mb = (N_META + jnp.arange(BLOCK))[None, :] - pq[:, None]
    out_meta = band_softmax(
        q[:, :N_META], k_m, v_m, k_r[:, :BLOCK], v_r[:, :BLOCK],
        jnp.transpose(tab[t5_bucket(rel_mm)], (2, 3, 0, 1)),
        jnp.transpose(tab[t5_bucket(rel_mb)], (2, 3, 0, 1)),
        rel_mb <= WINDOW, sink)
    qb = q[:, N_META:].reshape(B, nb, BLOCK, Hk, G, d)
    pad = ((0, 0), (1, 1), (0, 0), (0, 0), (0, 0))
    kp = jnp.pad(k_r.reshape(B, nb, BLOCK, Hk, d), pad)
    vp = jnp.pad(v_r.reshape(B, nb, BLOCK, Hk, d), pad)
    k_band = jnp.concatenate([kp[:, :-2], kp[:, 1:-1], kp[:, 2:]], 2)
    v_band = jnp.concatenate([vp[:, :-2], vp[:, 1:-1], vp[:, 2:]], 2)
    iq = jnp.arange(BLOCK)
    ik = jnp.arange(3 * BLOCK)
    blk = jnp.arange(nb)
    rel_b = (ik[None, :] - BLOCK) - iq[:, None]
    key_idx = BLOCK * (blk[:, None] - 1) + ik[None, :]
    in_range = (key_idx >= 0) & (key_idx < L)
    valid_b = ((jnp.abs(rel_b) <= WINDOW)[None] & in_range[:, None, :])[:, None, None]
    rel_m = jnp.arange(N_META)[None, None, :] - (N_META + BLOCK * blk[:, None, None] + iq[None, :, None])
    bias_m = jnp.transpose(tab[t5_bucket(rel_m)], (0, 3, 4, 1, 2))
    bias_b = jnp.transpose(tab[t5_bucket(rel_b)], (2, 3, 0, 1))
    km_b = jnp.broadcast_to(k_m[:, None], (B, nb, N_META, Hk, d))
    vm_b = jnp.broadcast_to(v_m[:, None], (B, nb, N_META, Hk, d))
    out_real = band_softmax(qb, km_b, vm_b, k_band, v_band, bias_m, bias_b, valid_b, sink)
    out = jnp.concatenate([out_meta.reshape(B, N_META, SWA_WIDTH), out_real.reshape(B, L, SWA_WIDTH)], 1)
    return out.astype(p.dtype)


def rope(x, pos):
    half = MLA_ROPE_DIM // 2
    inv = ROPE_THETA ** (-jnp.arange(half, dtype=jnp.float32) / half)
    ang = pos[:, None].astype(jnp.float32) * inv
    cos = jnp.cos(ang)[:, None, :]
    sin = jnp.sin(ang)[:, None, :]
    x1, x2 = x[..., :half], x[..., half:]
    return jnp.concatenate([x1 * cos - x2 * sin, x1 * sin + x2 * cos], -1)


def mla_mixer(p, q_a_norm, w_qb, kv_a_norm, w_kvb, q_norm, k_norm):
    B, T, _ = p.shape
    L = T - N_META
    nb = L // BLOCK
    H = MLA_HEADS
    q_a, kv_a, k_rope = jnp.split(p, [MLA_Q_RANK, MLA_Q_RANK + MLA_KV_RANK], -1)
    q = (rmsnorm(q_a, q_a_norm) @ w_qb).reshape(B, T, H, MLA_QK_DIM)
    kv = (rmsnorm(kv_a, kv_a_norm) @ w_kvb).reshape(B, T, H, MLA_NOPE_DIM + MLA_V_DIM)
    k_nope, v = kv[..., :MLA_NOPE_DIM], kv[..., MLA_NOPE_DIM:]
    k = jnp.concatenate([k_nope, jnp.broadcast_to(k_rope[:, :, None, :], (B, T, H, MLA_ROPE_DIM))], -1)
    q = rmsnorm(q, q_norm).astype(jnp.float32)
    k = rmsnorm(k, k_norm).astype(jnp.float32)
    pos = jnp.arange(T)
    q = jnp.concatenate([q[..., :MLA_NOPE_DIM], rope(q[..., MLA_NOPE_DIM:], pos)], -1) * MLA_QK_DIM ** -0.5
    k = jnp.concatenate([k[..., :MLA_NOPE_DIM], rope(k[..., MLA_NOPE_DIM:], pos)], -1)
    v = v.astype(jnp.float32)

    def attend(qb):
        s = jnp.einsum('bqhd,bkhd->bhqk', qb, k)
        return jnp.einsum('bhqk,bkhd->bqhd', jax.nn.softmax(s, -1), v)

    out_meta = attend(q[:, :N_META])
    q_blocks = jnp.moveaxis(q[:, N_META:].reshape(B, nb, BLOCK, H, MLA_QK_DIM), 1, 0)
    out_real = jnp.moveaxis(lax.map(attend, q_blocks), 0, 1).reshape(B, L, H, MLA_V_DIM)
    out = jnp.concatenate([out_meta, out_real], 1).reshape(B, T, MLA_WIDTH)
    return out.astype(p.dtype)


def setup_inputs(seed: int = 0) -> dict:
    key = jax.random.key(seed)
    ks = iter(jax.random.split(key, 40))
    f32 = jnp.float32
    nrm = lambda shape, scale: scale * jax.random.normal(next(ks), shape, f32)
    gain = lambda shape: 1.0 + 0.05 * jax.random.normal(next(ks), shape, f32)
    L, D = DEPTH, D_MODEL
    return {
        'x_prompt': nrm((BATCH, SEQ, D), 1.0),
        'x_sample': nrm((DEC_BATCH, DEC_SEQ, D), 1.0),
        'meta_tokens': nrm((N_META, D), 1.0),
        'rel_bias': nrm((REL_BUCKETS, SWA_Q_HEADS), 0.5),
        'ffn1_norm': gain((L, D)),
        'ffn1_w_gate': nrm((L, D, D_FF), D ** -0.5),
        'ffn1_w_up': nrm((L, D, D_FF), D ** -0.5),
        'ffn1_w_down': nrm((L, D_FF, D), D_FF ** -0.5),
        'mix_norm': gain((L, D)),
        'w_in': nrm((L, D, IN_COLS), D ** -0.5),
        'rwkv_mu': jax.random.uniform(next(ks), (L, RW_COLS), f32),
        'rwkv_w0': jax.random.uniform(next(ks), (L, 2, RW_WIDTH), f32, minval=-3.0, maxval=1.0),
        'rwkv_w2': nrm((L, 2, RW_DECAY_RANK, RW_WIDTH), 0.1 * RW_DECAY_RANK ** -0.5),
        'rwkv_a0': nrm((L, 2, RW_WIDTH), 0.1),
        'rwkv_a2': nrm((L, 2, RW_A_RANK, RW_WIDTH), 0.1 * RW_A_RANK ** -0.5),
        'rwkv_g2': nrm((L, RW_GATE_RANK, RW_WIDTH), RW_GATE_RANK ** -0.5),
        'rwkv_k_k': 0.85 + nrm((L, RW_WIDTH), 0.05),
        'rwkv_k_a': gain((L, RW_WIDTH)),
        'rwkv_r_k': nrm((L, RW_HEADS, RW_HEAD_DIM), 0.1),
        'rwkv_ln_g': gain((L, RW_WIDTH)),
        'rwkv_ln_b': nrm((L, RW_WIDTH), 0.02),
        'swa_q_norm': gain((L, SWA_HEAD_DIM)),
        'swa_k_norm': gain((L, SWA_HEAD_DIM)),
        'swa_sink': nrm((L, SWA_Q_HEADS), 0.5),
        'mla_q_a_norm': gain((L, MLA_Q_RANK)),
        'mla_w_qb': nrm((L, MLA_Q_RANK, MLA_HEADS * MLA_QK_DIM), MLA_Q_RANK ** -0.5),
        'mla_kv_a_norm': gain((L, MLA_KV_RANK)),
        'mla_w_kvb': nrm((L, MLA_KV_RANK, MLA_HEADS * (MLA_NOPE_DIM + MLA_V_DIM)), MLA_KV_RANK ** -0.5),
        'mla_q_norm': gain((L, MLA_QK_DIM)),
        'mla_k_norm': gain((L, MLA_QK_DIM)),
        'w_out': nrm((L, MIX_WIDTH, D), MIX_WIDTH ** -0.5),
        'ffn2_norm': gain((L, D)),
        'ffn2_w_gate': nrm((L, D, D_FF), D ** -0.5),
        'ffn2_w_up': nrm((L, D, D_FF), D ** -0.5),
        'ffn2_w_down': nrm((L, D_FF, D), D_FF ** -0.5),
        'final_norm': gain((L, D)),
    }


def reference(x_prompt, x_sample, meta_tokens, rel_bias, ffn1_norm, ffn1_w_gate, ffn1_w_up, ffn1_w_down,
              mix_norm, w_in, rwkv_mu, rwkv_w0, rwkv_w2, rwkv_a0, rwkv_a2, rwkv_g2, rwkv_k_k, rwkv_k_a,
              rwkv_r_k, rwkv_ln_g, rwkv_ln_b, swa_q_norm, swa_k_norm, swa_sink, mla_q_a_norm, mla_w_qb,
              mla_kv_a_norm, mla_w_kvb, mla_q_norm, mla_k_norm, w_out, ffn2_norm, ffn2_w_gate, ffn2_w_up,
              ffn2_w_down, final_norm):
    def run(x):
        B = x.shape[0]
        meta = jnp.broadcast_to(meta_tokens[None].astype(x.dtype), (B, N_META, D_MODEL))
        h = jnp.concatenate([meta, x], 1)
        for l in range(DEPTH):
            h = h + 0.5 * swiglu(rmsnorm(h, ffn1_norm[l]), ffn1_w_gate[l], ffn1_w_up[l], ffn1_w_down[l])
            p = rmsnorm(h, mix_norm[l]) @ w_in[l]
            p_rw, p_swa, p_mla = jnp.split(p, [RW_COLS, RW_COLS + SWA_COLS], -1)
            y_rw = rwkv7_mixer(p_rw, rwkv_mu[l], rwkv_w0[l], rwkv_w2[l], rwkv_a0[l], rwkv_a2[l], rwkv_g2[l],
                               rwkv_k_k[l], rwkv_k_a[l], rwkv_r_k[l], rwkv_ln_g[l], rwkv_ln_b[l])
            y_swa = swa_mixer(p_swa, swa_q_norm[l], swa_k_norm[l], swa_sink[l], rel_bias)
            y_mla = mla_mixer(p_mla, mla_q_a_norm[l], mla_w_qb[l], mla_kv_a_norm[l], mla_w_kvb[l],
                              mla_q_norm[l], mla_k_norm[l])
            mix = jnp.concatenate([y_rw, y_swa, y_mla], -1).astype(h.dtype)
            h = h + mix @ w_out[l]
            h = h + 0.5 * swiglu(rmsnorm(h, ffn2_norm[l]), ffn2_w_gate[l], ffn2_w_up[l], ffn2_w_down[l])
            h = rmsnorm(h, final_norm[l])
        return h[:, N_META:]

    y_prompt = run(x_prompt)
    y_sample = run(x_sample)
    return (y_prompt, y_sample)
```

```cpp
#include <hip/hip_runtime.h>
#include <hip/hip_cooperative_groups.h>
#include <cstdio>
namespace cg = cooperative_groups;

#define DI __device__ __forceinline__
#define LAS __attribute__((address_space(3)))
typedef unsigned short bf16_t;
typedef short bf16x8 __attribute__((ext_vector_type(8)));
typedef short s16x4 __attribute__((ext_vector_type(4)));
typedef float f32x2 __attribute__((ext_vector_type(2)));
typedef float f32x4 __attribute__((ext_vector_type(4)));
typedef float f32x16 __attribute__((ext_vector_type(16)));
typedef unsigned u32x2 __attribute__((ext_vector_type(2)));
typedef unsigned u32x4 __attribute__((ext_vector_type(4)));
typedef __bf16 bf16v2 __attribute__((ext_vector_type(2)));

constexpr int D = 1024, DFF = 2816, NSEQ = 33, TP = 16400, TS = 2064, MTOK = 82448, MPAD = 82688;
constexpr int NCP = 129, NCS = 17, NCH = NCP + 32 * NCS;
constexpr float EPS = 1e-6f, LOG2E = 1.4426950408889634f;
constexpr int PLD = 2304;
constexpr size_t U1 = (size_t)MPAD * 256 * 2;
constexpr size_t OFF_H = 0;
constexpr size_t OFF_W = 8 * U1;
constexpr size_t W_GU = 0, W_D = W_GU + (size_t)5632 * 1024, W_GU2 = W_D + (size_t)1024 * 2816, W_D2 = W_GU2 + (size_t)5632 * 1024,
                 W_IN = W_D2 + (size_t)1024 * 2816, W_VS = W_IN + (size_t)2304 * 1024, W_LR = W_VS + (size_t)256 * 1024, W_QB = W_LR + (size_t)1280 * 256,
                 W_KN = W_QB + (size_t)512 * 256, W_KV = W_KN + (size_t)256 * 256, W_OUT = W_KV + (size_t)256 * 256, W_LAYER = W_OUT + (size_t)1024 * 1024;
constexpr size_t OFF_CTL = OFF_W + 2 * W_LAYER * 2;
constexpr size_t CTL_BYTES = 32768;
constexpr size_t OFF_R = OFF_CTL + CTL_BYTES;
constexpr size_t OFF_SS1 = OFF_R + 15 * U1, OFF_SS2 = OFF_SS1 + (size_t)MPAD * 64;
constexpr size_t WS_NEED = OFF_SS2 + (size_t)MPAD * 64;
static_assert(WS_NEED <= (size_t)1073741824, "workspace plan exceeds 1 GiB");
static_assert(OFF_R % 256 == 0 && OFF_W % 256 == 0, "align");
constexpr size_t R_ACT = OFF_R, R_P = OFF_R, R_VTS = OFF_R + 9 * U1, R_RR = OFF_R + 10 * U1, R_KK = OFF_R + 11 * U1, R_VV = OFF_R + 12 * U1,
                 R_SW = OFF_R, R_AA = OFF_R + 2 * U1, R_G = OFF_R + 4 * U1, R_QM = OFF_R + 5 * U1, R_KM = OFF_R + 5 * U1 + U1 * 3 / 2, R_VTM = OFF_R + 8 * U1,
                 R_Z = OFF_R + 13 * U1, R_MIX = OFF_R;
constexpr size_t O_XN = 0, O_QS = 0, O_KS = 2 * U1, O_ASM = U1 * 5 / 2, O_QA = U1 * 7 / 2, O_KVA = U1 * 9 / 2,
                 O_YL = U1 * 5 / 2, O_U = U1 * 9 / 2, O_PT = O_U + (size_t)NCH * 8 * 8192, O_INV = O_PT + (size_t)NCH * 8 * 8192,
                 O_BON = O_INV + (size_t)MPAD * 16, O_KR = O_BON + (size_t)MPAD * 16, O_END = O_KR + (size_t)MPAD * 64;
static_assert(O_END <= (size_t)82432 * 1024 * 4, "d_out scratch plan too big");
static_assert(O_U % 16 == 0 && O_PT % 16 == 0 && O_INV % 16 == 0 && O_KR % 16 == 0, "align");
constexpr int LDS_BYTES = 132096;

struct Params { const float* in[36]; float* out; unsigned char* ws; };

DI int tid_(int wv) {
    int ln = __builtin_amdgcn_mbcnt_hi(~0u, __builtin_amdgcn_mbcnt_lo(~0u, 0u)); asm volatile("" : "+v"(ln)); return wv * 64 + ln; }
DI float bf2f(bf16_t b) { return __uint_as_float(((unsigned)b) << 16); }
DI unsigned pack2(float lo, float hi) { f32x2 v = {lo, hi}; bf16v2 r = __builtin_convertvector(v, bf16v2); return __builtin_bit_cast(unsigned, r); }
DI bf16_t f2bf(float f) { return (bf16_t)(pack2(f, 0.f) & 0xffffu); }
DI float lo_bf(unsigned u) { return __uint_as_float(u << 16); }
DI float hi_bf(unsigned u) { return __uint_as_float(u & 0xffff0000u); }
DI float fexp2(float x) { return __builtin_amdgcn_exp2f(x); }
DI float frcp(float x) { return __builtin_amdgcn_rcpf(x); }
DI float sigmoidf_(float x) { return frcp(1.f + fexp2(-x * LOG2E)); }
DI int seq_start(int s) { return s == 0 ? 0 : TP + (s - 1) * TS; }
DI int seq_len(int s) { return s == 0 ? TP : TS; }
DI int row_seq(int row) { return row < TP ? 0 : 1 + (row - TP) / TS; }
DI float shx(float v, int lane, int o) { return __int_as_float(__builtin_amdgcn_ds_bpermute((lane ^ o) << 2, __float_as_int(v))); }
template <int W> DI float xsum_(float v, int lane) {
#pragma unroll
    for (int o = 1; o < W; o <<= 1) v += shx(v, lane, o);
    return v;
}

namespace pg8 {
constexpr int BM = 256, BK = 64, HALF = 128, HTB = HALF * BK * 2, STAGE_BYTES = 8 * HTB, NXCD = 8, WGM = 8;
DI int lds_byte(int r, int c) { const int st = (r >> 4) * 2 + (c >> 5), rr = r & 15, cc = c & 31, ob = rr * 64 + cc * 2; return st * 1024 + (ob ^ (((ob >> 9) & 1) << 5)); }
DI void stage_rc(int b, int& R, int& C) { const int st = b / 1024, sb = b % 1024, swz = sb ^ (((sb >> 9) & 1) << 5); R = (st >> 1) * 16 + swz / 64; C = (st & 1) * 32 + (swz % 64) / 2; }
DI int perm32(int rho) { const int n = rho >> 4, i = rho & 15; return 8 * (i >> 2) + 4 * n + (i & 3); }
struct Unit { int pm, pn; };
struct Gemm { const bf16_t* A; const bf16_t* Bt; int M, N, K; };
struct StaticOrder {
    int nM, nN, nwg, G, c;
    DI void init(int M, int N, int G_, int c_) { nM = M / BM; nN = N / BM; nwg = nM * nN; G = G_; c = c_; }
    DI bool next(int i, Unit& u) const {
        const long L = (long)i * G + c; if (L >= nwg) return false;
        int wgid = (int)L; { const int q = nwg / NXCD, r = nwg % NXCD, xcd = wgid % NXCD, off = wgid / NXCD; wgid = (xcd < r ? xcd * (q + 1) : r * (q + 1) + (xcd - r) * q) + off; }
        const int nig = WGM * nN, gid = wgid / nig, fm = gid * WGM, gsz = (nM - fm) < WGM ? (nM - fm) : WGM;
        u.pm = fm + ((wgid % nig) % gsz); u.pn = (wgid % nig) / gsz; return true;
    }
};
template <class Epi>
DI void gemm_phase(int wv, LAS unsigned char* lds, const Gemm g, const StaticOrder& S, const Epi& E) {
    const int tid = tid_(wv), wid = __builtin_amdgcn_readfirstlane(tid >> 6), lane = tid & 63, wr = wid >> 2, wc = wid & 3, fr = lane & 15, fq = lane >> 4;
    const int K = g.K, nt = K / BK;
    unsigned voffA[2], voffB[2];
#pragma unroll
    for (int i = 0; i < 2; ++i) { int R, C; stage_rc(tid * 16 + i * 8192, R, C); const int Rb = Epi::PERM ? ((R & ~31) + perm32(R & 31)) : R; voffA[i] = (unsigned)(R * K + C) * 2u; voffB[i] = (unsigned)(Rb * K + C) * 2u; }
    const size_t kstep = (size_t)(BK * 2);
    const size_t hstep = (size_t)HALF * K * 2;
    const size_t tstep = 2 * hstep;
    const unsigned ldsw = (unsigned)wid * 1024u;
    const int aoff = lds_byte(wr * 64 + fr, fq * 8), boff = lds_byte(wc * 32 + fr, fq * 8);
#define PG8_SA(b, h) (((b) * 2 + (h)) * HTB)
#define PG8_SB(b, h) ((4 + (b) * 2 + (h)) * HTB)
#define PG8_STAGE(bufoff, gbase, voff) do { _Pragma("unroll") for (int _i = 0; _i < 2; ++_i) \
        __builtin_amdgcn_global_load_lds((const unsigned*)((const char*)(gbase) + (voff)[_i]), (LAS unsigned*)(lds + (bufoff) + ldsw + _i * 8192), 16, 0, 0); } while (0)
#define PG8_LDA(dst, b, h) do { _Pragma("unroll") for (int m = 0; m < 4; ++m) _Pragma("unroll") for (int k = 0; k < 2; ++k) dst[m][k] = *(const LAS bf16x8*)(lds + PG8_SA(b, h) + aoff + m * 2048 + k * 1024); } while (0)
#define PG8_LDB(dst, b, h) do { _Pragma("unroll") for (int n = 0; n < 2; ++n) _Pragma("unroll") for (int k = 0; k < 2; ++k) dst[n][k] = *(const LAS bf16x8*)(lds + PG8_SB(b, h) + boff + n * 2048 + k * 1024); } while (0)
#define PG8_MMA(ai, bj, At, Bt) do { __builtin_amdgcn_s_setprio(1); _Pragma("unroll") for (int m = 0; m < 4; ++m) _Pragma("unroll") for (int n = 0; n < 2; ++n) _Pragma("unroll") for (int k = 0; k < 2; ++k) \
        acc[ai][bj][m][n] = __builtin_amdgcn_mfma_f32_16x16x32_bf16(Bt[n][k], At[m][k], acc[ai][bj][m][n], 0, 0, 0); __builtin_amdgcn_s_setprio(0); } while (0)
#define PG8_WAIT_V(n) asm volatile("s_waitcnt vmcnt(" #n ")" ::: "memory")
#define PG8_WAIT_L(n) asm volatile("s_waitcnt lgkmcnt(" #n ")" ::: "memory")
#define PG8_BAR __builtin_amdgcn_s_barrier()
#define PG8_SCHED __builtin_amdgcn_sched_barrier(0)
    Unit cur, nxt; int ui = 0;
    if (!S.next(0, cur)) return;
    f32x4 acc[2][2][4][2];
#pragma unroll
    for (int a = 0; a < 2; ++a)
#pragma unroll
        for (int b = 0; b < 2; ++b)
#pragma unroll
            for (int m = 0; m < 4; ++m)
#pragma unroll
                for (int n = 0; n < 2; ++n) acc[a][b][m][n] = (f32x4){0.f, 0.f, 0.f, 0.f};
    bf16x8 At[4][2], B0[2][2], B1[2][2];
    const char* cA = (const char*)g.A + (size_t)cur.pm * tstep; const char* cB = (const char*)g.Bt + (size_t)cur.pn * tstep;
    PG8_STAGE(PG8_SB(0, 0), cB, voffB); PG8_STAGE(PG8_SA(0, 0), cA, voffA); PG8_STAGE(PG8_SB(0, 1), cB + hstep, voffB); PG8_STAGE(PG8_SA(0, 1), cA + hstep, voffA);
    if (wr == 1) PG8_BAR;
    PG8_WAIT_V(4); PG8_BAR;
    PG8_STAGE(PG8_SB(1, 0), cB + kstep, voffB); PG8_STAGE(PG8_SA(1, 0), cA + kstep, voffA); PG8_STAGE(PG8_SB(1, 1), cB + hstep + kstep, voffB);
    PG8_WAIT_V(6); PG8_BAR;
    for (;;) {
        const bool has_next = S.next(ui + 1, nxt);
        const char* nA = has_next ? (const char*)g.A + (size_t)nxt.pm * tstep : cA; const char* nB = has_next ? (const char*)g.Bt + (size_t)nxt.pn * tstep : cB;
        for (int t = 0; t < nt; t += 2) {
            const bool last = (t == nt - 2);
            const char* a1 = cA + (size_t)(t + 1) * kstep;
            const char* a2 = last ? nA : cA + (size_t)(t + 2) * kstep; const char* b2 = last ? nB : cB + (size_t)(t + 2) * kstep;
            const char* a3 = a2 + kstep; const char* b3 = b2 + kstep;
            PG8_LDB(B0, 0, 0); PG8_SCHED; PG8_LDA(At, 0, 0); PG8_STAGE(PG8_SA(1, 1), a1 + hstep, voffA);
            PG8_WAIT_L(8); PG8_BAR; PG8_WAIT_L(0); PG8_MMA(0, 0, At, B0); PG8_BAR; PG8_SCHED;
            PG8_LDB(B1, 0, 1); PG8_STAGE(PG8_SB(0, 0), b2, voffB);
            PG8_BAR; PG8_WAIT_L(0); PG8_MMA(0, 1, At, B1); PG8_BAR;
            PG8_LDA(At, 0, 1); PG8_STAGE(PG8_SA(0, 0), a2, voffA);
            PG8_BAR; PG8_WAIT_L(0); PG8_MMA(1, 0, At, B0); PG8_BAR; PG8_SCHED;
            PG8_STAGE(PG8_SB(0, 1), b2 + hstep, voffB);
            PG8_WAIT_V(6); PG8_BAR; PG8_MMA(1, 1, At, B1); PG8_BAR;
            PG8_LDB(B0, 1, 0); PG8_SCHED; PG8_LDA(At, 1, 0); PG8_STAGE(PG8_SA(0, 1), a2 + hstep, voffA);
            PG8_WAIT_L(8); PG8_BAR; PG8_WAIT_L(0); PG8_MMA(0, 0, At, B0); PG8_BAR; PG8_SCHED;
            PG8_LDB(B1, 1, 1); PG8_STAGE(PG8_SB(1, 0), b3, voffB);
            PG8_BAR; PG8_WAIT_L(0); PG8_MMA(0, 1, At, B1); PG8_BAR;
            PG8_LDA(At, 1, 1); PG8_STAGE(PG8_SA(1, 0), a3, voffA);
            PG8_BAR; PG8_WAIT_L(0); PG8_MMA(1, 0, At, B0); PG8_BAR; PG8_SCHED;
            PG8_STAGE(PG8_SB(1, 1), b3 + hstep, voffB);
            PG8_WAIT_V(6); PG8_BAR; PG8_MMA(1, 1, At, B1); PG8_BAR;
        }
        E(acc, cur, wr, wc, fr, fq);
        if (!has_next) break;
#pragma unroll
        for (int a = 0; a < 2; ++a)
#pragma unroll
            for (int b = 0; b < 2; ++b)
#pragma unroll
                for (int m = 0; m < 4; ++m)
#pragma unroll
                    for (int n = 0; n < 2; ++n) acc[a][b][m][n] = (f32x4){0.f, 0.f, 0.f, 0.f};
        cur = nxt; cA = nA; cB = nB; ++ui;
    }
    PG8_WAIT_V(0);
    if (wr == 0) PG8_BAR;
    PG8_BAR;
#undef PG8_SA
#undef PG8_SB
#undef PG8_STAGE
#undef PG8_LDA
#undef PG8_LDB
#undef PG8_MMA
#undef PG8_WAIT_V
#undef PG8_WAIT_L
#undef PG8_BAR
#undef PG8_SCHED
}
}
using pg8::Unit;
typedef f32x4 AccT[2][2][4][2];

struct EpiSwiglu {
    static constexpr bool PERM = true;
    bf16_t* O;
    DI void operator()(const AccT& acc, const Unit& u, int wr, int wc, int fr, int fq) const {
#pragma unroll
        for (int ai = 0; ai < 2; ++ai)
#pragma unroll
            for (int m = 0; m < 4; ++m) {
                const size_t row = (size_t)u.pm * 256 + ai * 128 + wr * 64 + m * 16 + fr;
                float o[8];
#pragma unroll
                for (int n = 0; n < 2; ++n) {
                    const f32x4 g = acc[ai][0][m][n], up = acc[ai][1][m][n];
#pragma unroll
                    for (int e = 0; e < 4; ++e) o[4 * n + e] = g[e] * sigmoidf_(g[e]) * up[e];
                }
                u32x4 pk = {pack2(o[0], o[1]), pack2(o[2], o[3]), pack2(o[4], o[5]), pack2(o[6], o[7])};
                *(u32x4*)(O + row * DFF + u.pn * 128 + wc * 32 + 8 * fq) = pk;
            }
    }
};
struct EpiRes {
    static constexpr bool PERM = false;
    float* H; float alpha;
    DI void operator()(const AccT& acc, const Unit& u, int wr, int wc, int fr, int fq) const {
#pragma unroll
        for (int ai = 0; ai < 2; ++ai) {
            f32x4 h[4][2][2];
            float* base = H + ((size_t)u.pm * 256 + ai * 128 + wr * 64 + fr) * 1024 + u.pn * 256 + wc * 32 + 4 * fq;
#pragma unroll
            for (int m = 0; m < 4; ++m)
#pragma unroll
                for (int bj = 0; bj < 2; ++bj)
#pragma unroll
                    for (int n = 0; n < 2; ++n) h[m][bj][n] = *(const f32x4*)(base + (size_t)m * 16 * 1024 + bj * 128 + n * 16);
            __builtin_amdgcn_sched_barrier(0);
#pragma unroll
            for (int m = 0; m < 4; ++m)
#pragma unroll
                for (int bj = 0; bj < 2; ++bj)
#pragma unroll
                    for (int n = 0; n < 2; ++n) *(f32x4*)(base + (size_t)m * 16 * 1024 + bj * 128 + n * 16) = h[m][bj][n] + acc[ai][bj][m][n] * alpha;
        }
    }
};
template <int MODE> struct EpiSt {
    static constexpr bool PERM = true;
    bf16_t* O; size_t ld; int ncols;
    DI void operator()(const AccT& acc, const Unit& u, int wr, int wc, int fr, int fq) const {
#pragma unroll
        for (int ai = 0; ai < 2; ++ai)
#pragma unroll
            for (int m = 0; m < 4; ++m) {
                const size_t row = (size_t)u.pm * 256 + ai * 128 + wr * 64 + m * 16 + fr;
#pragma unroll
                for (int bj = 0; bj < 2; ++bj) {
                    const int col = u.pn * 256 + bj * 128 + wc * 32 + 8 * fq;
                    if (col < ncols) {
                        const int oc = MODE == 1 ? (col >> 6) * 96 + (col & 63) : col;
                        const f32x4 v0 = acc[ai][bj][m][0], v1 = acc[ai][bj][m][1];
                        u32x4 pk = {pack2(v0[0], v0[1]), pack2(v0[2], v0[3]), pack2(v1[0], v1[1]), pack2(v1[2], v1[3])};
                        *(u32x4*)(O + row * ld + oc) = pk;
                    }
                }
            }
    }
};
struct EpiLr {
    static constexpr bool PERM = true;
    bf16_t *SW, *AA, *G; const float *w0, *a0;
    DI void operator()(const AccT& acc, const Unit& u, int wr, int wc, int fr, int fq) const {
        const int kind = u.pn >> 1, d = u.pn & 1;
        const float* bias = kind == 0 ? w0 + d * 256 : a0 + d * 256;
        bf16_t* dst0 = kind == 0 ? SW + (size_t)d * MPAD * 256 : (kind == 1 ? AA + (size_t)d * MPAD * 256 : G);
        const float sc = kind == 0 ? 0.6065306597126334f : 1.0f;
#pragma unroll
        for (int bj = 0; bj < 2; ++bj) {
            const int c = bj * 128 + wc * 32 + 8 * fq;
            f32x4 b0 = {0.f, 0.f, 0.f, 0.f}, b1 = b0;
            if (kind < 2) { b0 = *(const f32x4*)(bias + c); b1 = *(const f32x4*)(bias + c + 4); }
#pragma unroll
            for (int ai = 0; ai < 2; ++ai)
#pragma unroll
                for (int m = 0; m < 4; ++m) {
                    const size_t row = (size_t)u.pm * 256 + ai * 128 + wr * 64 + m * 16 + fr;
                    const f32x4 v0 = acc[ai][bj][m][0], v1 = acc[ai][bj][m][1];
                    float o[8];
#pragma unroll
                    for (int e = 0; e < 4; ++e) { o[e] = kind < 2 ? sc * sigmoidf_(v0[e] + b0[e]) : v0[e]; o[4 + e] = kind < 2 ? sc * sigmoidf_(v1[e] + b1[e]) : v1[e]; }
                    u32x4 pk = {pack2(o[0], o[1]), pack2(o[2], o[3]), pack2(o[4], o[5]), pack2(o[6], o[7])};
                    *(u32x4*)(dst0 + row * 256 + c) = pk;
                }
        }
    }
};
template <class Epi> DI void run_gemm(int wv, LAS unsigned char* lds, const bf16_t* A, const bf16_t* Bt, int M, int N, int K, const Epi& E) {
    pg8::Gemm g{A, Bt, M, N, K}; pg8::StaticOrder S; S.init(M, N, (int)gridDim.x, (int)blockIdx.x);
    pg8::gemm_phase<Epi>(wv, lds, g, S, E);
}

enum { J_GU1, J_D1, J_GU2, J_D2, J_IN, J_VS, J_LR, J_QB, J_KN, J_KV, J_OUT, J_COUNT };
DI void wsrc_row(const Params& p, int job, int l, int n, const float*& base, int& stride, int& klo, int& khi) {
    klo = 0;
    switch (job) {
    case J_GU1: case J_GU2: { const int w = n & 255, c = (n >> 8) * 128 + (w & 127); const float* s = (w < 128) ? p.in[job == J_GU1 ? 5 : 32] : p.in[job == J_GU1 ? 6 : 33];
        base = s + (size_t)l * 1024 * DFF + c; stride = DFF; khi = 1024; break; }
    case J_D1: case J_D2: base = p.in[job == J_D1 ? 7 : 34] + (size_t)l * DFF * 1024 + n; stride = 1024; khi = DFF; break;
    case J_IN: { const int c = n < 1664 ? n : n + 128; base = p.in[9] + (size_t)l * 1024 * 2208 + (n < 2080 ? c : 0); stride = 2208; khi = n < 2080 ? 1024 : 0; break; }
    case J_VS: base = p.in[9] + (size_t)l * 1024 * 2208 + 1664 + (n < 128 ? n : 0); stride = 2208; khi = n < 128 ? 1024 : 0; break;
    case J_LR:
        if (n < 512) { const int d = n >> 8, c = n & 255; base = p.in[12] + ((size_t)l * 2 + d) * 64 * 256 + c; stride = 256; klo = 0; khi = 64; }
        else if (n < 1024) { const int d = (n - 512) >> 8, c = n & 255; base = p.in[14] + ((size_t)l * 2 + d) * 64 * 256 + c; stride = 256; klo = 64; khi = 128; }
        else { base = p.in[15] + (size_t)l * 128 * 256 + (n - 1024); stride = 256; klo = 128; khi = 256; }
        break;
    case J_QB: base = p.in[25] + (size_t)l * 256 * 384 + (n < 384 ? n : 0); stride = 384; khi = n < 384 ? 256 : 0; break;
    case J_KN: base = p.in[27] + (size_t)l * 128 * 512 + (n >> 6) * 128 + (n & 63); stride = 512; khi = 128; break;
    case J_KV: base = p.in[27] + (size_t)l * 128 * 512 + (n >> 6) * 128 + 64 + (n & 63); stride = 512; khi = 128; break;
    default: base = p.in[30] + (size_t)l * 1024 * 1024 + n; stride = 1024; khi = 1024; break;
    }
}
DI void job_shape(int job, int& N, int& K, size_t& off) {
    switch (job) {
    case J_GU1: N = 5632; K = 1024; off = W_GU; break;   case J_D1: N = 1024; K = 2816; off = W_D; break;
    case J_GU2: N = 5632; K = 1024; off = W_GU2; break;  case J_D2: N = 1024; K = 2816; off = W_D2; break;
    case J_IN: N = 2304; K = 1024; off = W_IN; break;    case J_VS: N = 256; K = 1024; off = W_VS; break;
    case J_LR: N = 1280; K = 256; off = W_LR; break;     case J_QB: N = 512; K = 256; off = W_QB; break;
    case J_KN: N = 256; K = 256; off = W_KN; break;      case J_KV: N = 256; K = 256; off = W_KV; break;
    default: N = 1024; K = 1024; off = W_OUT; break;
    }
}
DI void phase_weights(int wv, const Params& p, int l, int job_lo, int job_hi, int vgrid, int vblock) {
    bf16_t* W = (bf16_t*)(p.ws + OFF_W);
    const size_t gtid = (size_t)vblock * 512 + tid_(wv), gsz = (size_t)vgrid * 512;
        for (int job = job_lo; job < job_hi; ++job) {
            int N, K; size_t off; job_shape(job, N, K, off);
            bf16_t* dst = W + (size_t)l * W_LAYER + off;
            const size_t ntile = (size_t)(N / 8) * (K / 64);
            const int lane = (int)(gtid & 63), ln = lane >> 3, lk = lane & 7;
            const size_t wstep = gsz >> 6;
            for (size_t tile = gtid >> 6; tile < ntile; tile += 2 * wstep) {
                const size_t tile2 = tile + wstep; const bool has2 = tile2 < ntile;
                const int n = (int)(tile % (N / 8)) * 8 + ln, k0 = (int)(tile / (N / 8)) * 64 + lk * 8;
                const int n2 = has2 ? (int)(tile2 % (N / 8)) * 8 + ln : n, k2 = has2 ? (int)(tile2 / (N / 8)) * 64 + lk * 8 : k0;
                const float *b1, *b2; int st1, st2, lo1, hi1, lo2, hi2;
                wsrc_row(p, job, l, n, b1, st1, lo1, hi1); wsrc_row(p, job, l, n2, b2, st2, lo2, hi2);
                const bool in1 = k0 >= lo1 && k0 < hi1, in2 = k2 >= lo2 && k2 < hi2;
                const float* q1 = b1 + (size_t)(in1 ? k0 - lo1 : 0) * st1; const float* q2 = b2 + (size_t)(in2 ? k2 - lo2 : 0) * st2;
                float v[8], w[8];
#pragma unroll
                for (int j = 0; j < 8; ++j) { v[j] = q1[(size_t)j * st1]; w[j] = q2[(size_t)j * st2]; }
#pragma unroll
                for (int j = 0; j < 8; ++j) { v[j] = in1 ? v[j] : 0.f; w[j] = in2 ? w[j] : 0.f; }
                u32x4 pk = {pack2(v[0], v[1]), pack2(v[2], v[3]), pack2(v[4], v[5]), pack2(v[6], v[7])};
                *(u32x4*)(dst + (size_t)n * K + k0) = pk;
                if (has2) { u32x4 pk2 = {pack2(w[0], w[1]), pack2(w[2], w[3]), pack2(w[4], w[5]), pack2(w[6], w[7])}; *(u32x4*)(dst + (size_t)n2 * K + k2) = pk2; }
            }
        }
}

template <int MODE> DI void phase_norm(int wv, const Params& p, const float* g1, const float* gf, bool last) {
    float* H = (float*)(p.ws + OFF_H); bf16_t* XN = (bf16_t*)((unsigned char*)p.out + O_XN);
    const int tid = tid_(wv), lane = tid & 63, gw = blockIdx.x * 8 + (tid >> 6), nw = gridDim.x * 8;
    f32x4 gg[4], gfv[4];
#pragma unroll
    for (int q = 0; q < 4; ++q) { gg[q] = *(const f32x4*)(g1 + 4 * lane + 256 * q); if (MODE == 2) gfv[q] = *(const f32x4*)(gf + 4 * lane + 256 * q); }
    auto ld_row = [&](int row, f32x4 (&x)[4]) {
        if (MODE == 0) {
            const int s = row_seq(row), t = row - seq_start(s);
            const float* src = nullptr;
            if (row < MTOK) src = t < 16 ? p.in[2] + (size_t)t * D : (s == 0 ? p.in[0] + (size_t)(t - 16) * D : p.in[1] + ((size_t)(s - 1) * 2048 + (t - 16)) * D);
#pragma unroll
            for (int q = 0; q < 4; ++q) x[q] = src ? *(const f32x4*)(src + 4 * lane + 256 * q) : (f32x4){0.f, 0.f, 0.f, 0.f};
        } else {
#pragma unroll
            for (int q = 0; q < 4; ++q) x[q] = *(const f32x4*)(H + (size_t)row * D + 4 * lane + 256 * q);
        }
    };
    f32x4 xn[4];
    if (gw < MPAD) ld_row(gw, xn);
    for (int row = gw; row < MPAD; row += nw) {
        f32x4 x[4];
#pragma unroll
        for (int q = 0; q < 4; ++q) x[q] = xn[q];
        if (row + nw < MPAD) ld_row(row + nw, xn);
        const int s = row_seq(row), t = row - seq_start(s);
        if (MODE == 0) {
#pragma unroll
            for (int q = 0; q < 4; ++q) *(f32x4*)(H + (size_t)row * D + 4 * lane + 256 * q) = x[q];
        }
        float ss = 0.f;
#pragma unroll
        for (int q = 0; q < 4; ++q) ss += x[q][0] * x[q][0] + x[q][1] * x[q][1] + x[q][2] * x[q][2] + x[q][3] * x[q][3];
        ss = xsum_<64>(ss, lane);
        float rs = __builtin_amdgcn_rsqf(ss * (1.f / D) + EPS);
        if (MODE == 2) {
            float ss2 = 0.f;
#pragma unroll
            for (int q = 0; q < 4; ++q) { x[q] = x[q] * rs * gfv[q]; ss2 += x[q][0] * x[q][0] + x[q][1] * x[q][1] + x[q][2] * x[q][2] + x[q][3] * x[q][3]; }
            if (last) {
                if (row < MTOK && t >= 16) {
                    float* o = p.out + ((s == 0 ? (size_t)(t - 16) : (size_t)16384 + (size_t)(s - 1) * 2048 + (t - 16))) * D;
#pragma unroll
                    for (int q = 0; q < 4; ++q) *(f32x4*)(o + 4 * lane + 256 * q) = x[q];
                }
                continue;
            }
#pragma unroll
            for (int q = 0; q < 4; ++q) *(f32x4*)(H + (size_t)row * D + 4 * lane + 256 * q) = x[q];
            ss2 = xsum_<64>(ss2, lane);
            rs = __builtin_amdgcn_rsqf(ss2 * (1.f / D) + EPS);
        }
#pragma unroll
        for (int q = 0; q < 4; ++q) { const f32x4 y = x[q] * rs * gg[q]; u32x2 pk = {pack2(y[0], y[1]), pack2(y[2], y[3])}; *(u32x2*)(XN + (size_t)row * D + 4 * lane + 256 * q) = pk; }
    }
}

DI void phase_prep1(int wv, const Params& p, int l) {
    const bf16_t* P = (const bf16_t*)(p.ws + R_P);
    bf16_t* RR = (bf16_t*)(p.ws + R_RR); bf16_t* KK = (bf16_t*)(p.ws + R_KK); bf16_t* VV = (bf16_t*)(p.ws + R_VV);
    unsigned char* ob = (unsigned char*)p.out;
    bf16_t* QS = (bf16_t*)(ob + O_QS); bf16_t* KS = (bf16_t*)(ob + O_KS); bf16_t* ASM = (bf16_t*)(ob + O_ASM); bf16_t* QA = (bf16_t*)(ob + O_QA); bf16_t* KVA = (bf16_t*)(ob + O_KVA);
    float* INV = (float*)(ob + O_INV); float* BON = (float*)(ob + O_BON); bf16_t* KR = (bf16_t*)(ob + O_KR);
    const int tid = tid_(wv), lane = tid & 63, gw = blockIdx.x * 8 + (tid >> 6), nw = gridDim.x * 8;
    const float* mu = p.in[10] + (size_t)l * 1024;
    const int hd = lane >> 4;
    f32x4 mu_r = *(const f32x4*)(mu + 4 * lane), mu_k = *(const f32x4*)(mu + 256 + 4 * lane), mu_v = *(const f32x4*)(mu + 512 + 4 * lane);
    const float mu_w = mu[768 + lane], mu_a = mu[832 + lane], mu_g0 = mu[896 + 2 * lane], mu_g1 = mu[897 + 2 * lane];
    const f32x4 kk4 = *(const f32x4*)(p.in[16] + (size_t)l * 256 + 4 * lane), rk4 = *(const f32x4*)(p.in[18] + (size_t)l * 256 + 4 * lane);
    const float* qn = p.in[21] + (size_t)l * 64; const float* kn = p.in[22] + (size_t)l * 64;
    float qg[8];
#pragma unroll
    for (int e = 0; e < 8; ++e) qg[e] = qn[(8 * lane + e) & 63] * (0.125f * LOG2E);
    const float kg0 = kn[(2 * lane) & 63], kg1 = kn[(2 * lane + 1) & 63];
    const f32x4 qag = *(const f32x4*)(p.in[24] + (size_t)l * 256 + 4 * lane);
    const float kvg0 = p.in[26][(size_t)l * 128 + 2 * lane], kvg1 = p.in[26][(size_t)l * 128 + 2 * lane + 1];
    struct Raw { u32x2 c0, a0, b0, c1, a1, b1, c2, a2, b2, q2; u32x4 q4; unsigned gc, ga, gb, k2, kv, kr; bf16_t wc, wp, wn, ac, ap, an; };
    auto load_raw = [&](int row, Raw& R) {
        const int s = row_seq(row), t = row - seq_start(s), T = seq_len(s);
        const bf16_t* pc = P + (size_t)row * PLD;
        const bf16_t* pp = t > 0 ? pc - PLD : pc; const bf16_t* pn = t < T - 1 ? pc + PLD : pc;
        R.c0 = *(const u32x2*)(pc + 4 * lane); R.a0 = *(const u32x2*)(pp + 4 * lane); R.b0 = *(const u32x2*)(pn + 4 * lane);
        R.c1 = *(const u32x2*)(pc + 256 + 4 * lane); R.a1 = *(const u32x2*)(pp + 256 + 4 * lane); R.b1 = *(const u32x2*)(pn + 256 + 4 * lane);
        R.c2 = *(const u32x2*)(pc + 512 + 4 * lane); R.a2 = *(const u32x2*)(pp + 512 + 4 * lane); R.b2 = *(const u32x2*)(pn + 512 + 4 * lane);
        R.wc = pc[768 + lane]; R.wp = pp[768 + lane]; R.wn = pn[768 + lane]; R.ac = pc[832 + lane]; R.ap = pp[832 + lane]; R.an = pn[832 + lane];
        R.gc = *(const unsigned*)(pc + 896 + 2 * lane); R.ga = *(const unsigned*)(pp + 896 + 2 * lane); R.gb = *(const unsigned*)(pn + 896 + 2 * lane);
        R.q4 = *(const u32x4*)(pc + 1024 + 8 * lane); R.k2 = *(const unsigned*)(pc + 1536 + 2 * lane);
        R.q2 = *(const u32x2*)(pc + 1664 + 4 * lane); R.kv = *(const unsigned*)(pc + 1920 + 2 * lane);
        R.kr = *(const unsigned*)(pc + 2048 + 2 * (lane & 15));
    };
    Raw cur, nxt;
    if (gw < MTOK) load_raw(gw, cur);
    for (int row = gw; row < MTOK; row += nw) {
        if (row + nw < MTOK) load_raw(row + nw, nxt);
        const int s = row_seq(row), t = row - seq_start(s), T = seq_len(s);
        const float hp = t > 0 ? 0.5f : 0.f, hn = t < T - 1 ? 0.5f : 0.f;
        float r[4], k[4], v[4];
        {
            const u32x2 c0 = cur.c0, a0 = cur.a0, b0 = cur.b0, c1 = cur.c1, a1 = cur.a1, b1 = cur.b1, c2 = cur.c2, a2 = cur.a2, b2 = cur.b2;
#define MIX4(dst, c, a, b, m) do { float x0 = lo_bf(c[0]), x1 = hi_bf(c[0]), x2 = lo_bf(c[1]), x3 = hi_bf(c[1]); \
            dst[0] = x0 + m[0] * (hp * lo_bf(a[0]) + hn * lo_bf(b[0]) - x0); dst[1] = x1 + m[1] * (hp * hi_bf(a[0]) + hn * hi_bf(b[0]) - x1); \
            dst[2] = x2 + m[2] * (hp * lo_bf(a[1]) + hn * lo_bf(b[1]) - x2); dst[3] = x3 + m[3] * (hp * hi_bf(a[1]) + hn * hi_bf(b[1]) - x3); } while (0)
            MIX4(r, c0, a0, b0, mu_r); MIX4(k, c1, a1, b1, mu_k); MIX4(v, c2, a2, b2, mu_v);
#undef MIX4
        }
        float ssk = 0.f, bon = 0.f;
#pragma unroll
        for (int e = 0; e < 4; ++e) { const float q = k[e] * kk4[e]; ssk += q * q; bon += r[e] * k[e] * rk4[e]; }
        ssk = xsum_<16>(ssk, lane); bon = xsum_<16>(bon, lane);
        const float inv = 1.f / fmaxf(sqrtf(ssk), 1e-12f);
        if ((lane & 15) == 0) { INV[(size_t)row * 4 + hd] = inv; BON[(size_t)row * 4 + hd] = bon; }
        { u32x2 pk = {pack2(r[0], r[1]), pack2(r[2], r[3])}; *(u32x2*)(RR + (size_t)row * 256 + 4 * lane) = pk; }
        { u32x2 pk = {pack2(k[0], k[1]), pack2(k[2], k[3])}; *(u32x2*)(KK + (size_t)row * 256 + 4 * lane) = pk; }
        { u32x2 pk = {pack2(v[0], v[1]), pack2(v[2], v[3])}; *(u32x2*)(VV + (size_t)row * 256 + 4 * lane) = pk; }
        {
            float x = bf2f(cur.wc); x = x + mu_w * (hp * bf2f(cur.wp) + hn * bf2f(cur.wn) - x);
            const float e2 = fexp2(2.f * LOG2E * x); const float th = 1.f - 2.f * frcp(e2 + 1.f);
            ASM[(size_t)row * 256 + lane] = f2bf(th);
            float y = bf2f(cur.ac); y = y + mu_a * (hp * bf2f(cur.ap) + hn * bf2f(cur.an) - y);
            ASM[(size_t)row * 256 + 64 + lane] = f2bf(y);
            const unsigned gc = cur.gc, ga = cur.ga, gb = cur.gb;
            float g0 = lo_bf(gc), g1 = hi_bf(gc);
            g0 = g0 + mu_g0 * (hp * lo_bf(ga) + hn * lo_bf(gb) - g0); g1 = g1 + mu_g1 * (hp * hi_bf(ga) + hn * hi_bf(gb) - g1);
            *(unsigned*)(ASM + (size_t)row * 256 + 128 + 2 * lane) = pack2(sigmoidf_(g0), sigmoidf_(g1));
        }
        {
            const u32x4 q4 = cur.q4;
            float q[8] = {lo_bf(q4[0]), hi_bf(q4[0]), lo_bf(q4[1]), hi_bf(q4[1]), lo_bf(q4[2]), hi_bf(q4[2]), lo_bf(q4[3]), hi_bf(q4[3])};
            float ss = 0.f;
#pragma unroll
            for (int e = 0; e < 8; ++e) ss += q[e] * q[e];
            ss = xsum_<8>(ss, lane);
            const float rs = __builtin_amdgcn_rsqf(ss * (1.f / 64) + EPS);
            u32x4 o;
#pragma unroll
            for (int e = 0; e < 4; ++e) o[e] = pack2(q[2 * e] * rs * qg[2 * e], q[2 * e + 1] * rs * qg[2 * e + 1]);
            *(u32x4*)(QS + (size_t)row * 512 + 8 * lane) = o;
            const unsigned k2 = cur.k2;
            const float k0 = lo_bf(k2), k1 = hi_bf(k2);
            float sk = xsum_<32>(k0 * k0 + k1 * k1, lane);
            const float rk = __builtin_amdgcn_rsqf(sk * (1.f / 64) + EPS);
            *(unsigned*)(KS + (size_t)row * 128 + 2 * lane) = pack2(k0 * rk * kg0, k1 * rk * kg1);
        }
        {
            const u32x2 q2 = cur.q2;
            const float q0 = lo_bf(q2[0]), q1 = hi_bf(q2[0]), q2f = lo_bf(q2[1]), q3 = hi_bf(q2[1]);
            const float ss = xsum_<64>(q0 * q0 + q1 * q1 + q2f * q2f + q3 * q3, lane);
            const float rs = __builtin_amdgcn_rsqf(ss * (1.f / 256) + EPS);
            u32x2 o = {pack2(q0 * rs * qag[0], q1 * rs * qag[1]), pack2(q2f * rs * qag[2], q3 * rs * qag[3])};
            *(u32x2*)(QA + (size_t)row * 256 + 4 * lane) = o;
            const unsigned kv = cur.kv;
            const float a = lo_bf(kv), b = hi_bf(kv);
            const float s2 = xsum_<64>(a * a + b * b, lane);
            const float r2 = __builtin_amdgcn_rsqf(s2 * (1.f / 128) + EPS);
            *(unsigned*)(KVA + (size_t)row * 256 + 2 * lane) = pack2(a * r2 * kvg0, b * r2 * kvg1);
            *(unsigned*)(KVA + (size_t)row * 256 + 128 + 2 * lane) = 0u;
            if (lane < 16) *(unsigned*)(KR + (size_t)row * 32 + 2 * lane) = cur.kr;
        }
        cur = nxt;
    }
    for (int row = MTOK + gw; row < MPAD; row += nw) {
        *(u32x2*)(ASM + (size_t)row * 256 + 4 * lane) = (u32x2){0u, 0u};
        *(u32x2*)(QA + (size_t)row * 256 + 4 * lane) = (u32x2){0u, 0u};
        *(u32x2*)(KVA + (size_t)row * 256 + 4 * lane) = (u32x2){0u, 0u};
    }
}

DI void phase_prep2(int wv, const Params& p, int l) {
    bf16_t* QM = (bf16_t*)(p.ws + R_QM); bf16_t* KM = (bf16_t*)(p.ws + R_KM);
    const bf16_t* KR = (const bf16_t*)((unsigned char*)p.out + O_KR);
    const int tid = tid_(wv), lane = tid & 63, gw = blockIdx.x * 8 + (tid >> 6), nw = gridDim.x * 8;
    const int hd = lane >> 4, u = lane & 15;
    const float* qn = p.in[28] + (size_t)l * 96; const float* kn = p.in[29] + (size_t)l * 96;
    const f32x4 qg = *(const f32x4*)(qn + 4 * u), kg = *(const f32x4*)(kn + 4 * u);
    const float qg1 = qn[64 + u], qg2 = qn[80 + u], kg1 = kn[64 + u], kg2 = kn[80 + u];
    const float inv_f = fexp2(-(float)u * (13.287712379549449f / 16.f));
    const float qscale = 0.10206207261596577f * LOG2E;
    struct Raw2 { u32x2 qa, ka; bf16_t q1, q2, k1, k2; };
    auto ld2 = [&](int row, Raw2& R) {
        const bf16_t* q = QM + (size_t)row * 384 + hd * 96; const bf16_t* k = KM + (size_t)row * 384 + hd * 96;
        R.qa = *(const u32x2*)(q + 4 * u); R.q1 = q[64 + u]; R.q2 = q[80 + u];
        R.ka = *(const u32x2*)(k + 4 * u); R.k1 = KR[(size_t)row * 32 + u]; R.k2 = KR[(size_t)row * 32 + 16 + u];
    };
    Raw2 cur, nxt;
    if (gw < MTOK) ld2(gw, cur);
    for (int row = gw; row < MTOK; row += nw) {
        if (row + nw < MTOK) ld2(row + nw, nxt);
        const int s = row_seq(row), t = row - seq_start(s);
        const float ang = (float)t * inv_f;
        const double rev = (double)ang * 0.15915494309189535; const float fr = (float)(rev - __builtin_rint(rev));
        const float sn = __builtin_amdgcn_sinf(fr), cs = __builtin_amdgcn_cosf(fr);
        {
            bf16_t* q = QM + (size_t)row * 384 + hd * 96;
            const u32x2 a = cur.qa;
            float x[4] = {lo_bf(a[0]), hi_bf(a[0]), lo_bf(a[1]), hi_bf(a[1])};
            float x1 = bf2f(cur.q1), x2 = bf2f(cur.q2);
            float ss = x[0] * x[0] + x[1] * x[1] + x[2] * x[2] + x[3] * x[3] + x1 * x1 + x2 * x2;
            ss = xsum_<16>(ss, lane);
            const float rs = __builtin_amdgcn_rsqf(ss * (1.f / 96) + EPS) * qscale;
            u32x2 o = {pack2(x[0] * rs * qg[0], x[1] * rs * qg[1]), pack2(x[2] * rs * qg[2], x[3] * rs * qg[3])};
            x1 *= rs * qg1; x2 *= rs * qg2;
            *(u32x2*)(q + 4 * u) = o; q[64 + u] = f2bf(x1 * cs - x2 * sn); q[80 + u] = f2bf(x1 * sn + x2 * cs);
        }
        {
            bf16_t* k = KM + (size_t)row * 384 + hd * 96;
            const u32x2 a = cur.ka;
            float x[4] = {lo_bf(a[0]), hi_bf(a[0]), lo_bf(a[1]), hi_bf(a[1])};
            float x1 = bf2f(cur.k1), x2 = bf2f(cur.k2);
            float ss = x[0] * x[0] + x[1] * x[1] + x[2] * x[2] + x[3] * x[3] + x1 * x1 + x2 * x2;
            ss = xsum_<16>(ss, lane);
            const float rs = __builtin_amdgcn_rsqf(ss * (1.f / 96) + EPS);
            u32x2 o = {pack2(x[0] * rs * kg[0], x[1] * rs * kg[1]), pack2(x[2] * rs * kg[2], x[3] * rs * kg[3])};
            x1 *= rs * kg1; x2 *= rs * kg2;
            *(u32x2*)(k + 4 * u) = o; k[64 + u] = f2bf(x1 * cs - x2 * sn); k[80 + u] = f2bf(x1 * sn + x2 * cs);
        }
        cur = nxt;
    }
}

DI void chunk_decode(int g, int& seq, int& c) { if (g < NCP) { seq = 0; c = g; } else { seq = 1 + (g - NCP) / NCS; c = (g - NCP) % NCS; } }
DI void chunk_range(int c, int& t0, int& t1) { if (c == 0) { t0 = 0; t1 = 16; } else { t0 = 16 + 128 * (c - 1); t1 = t0 + 128; } }
DI float dpp_add(float x, const int ctrl_sel) {
    const int xi = __builtin_bit_cast(int, x);
    int yi;
    if (ctrl_sel == 0) yi = __builtin_amdgcn_update_dpp(0, xi, 0xB1, 0xf, 0xf, true);
    else if (ctrl_sel == 1) yi = __builtin_amdgcn_update_dpp(0, xi, 0x4E, 0xf, 0xf, true);
    else yi = __builtin_amdgcn_update_dpp(0, xi, 0x141, 0xf, 0xf, true);
    return x + __builtin_bit_cast(float, yi);
}
DI float allsum4(float x) { x = dpp_add(x, 0); x = dpp_add(x, 1); return x; }
template <int DIR> DI void scan_item(const Params& p, int l, LAS float* L, LAS float* CL, int item, int lane) {
    const bf16_t* RR = (const bf16_t*)(p.ws + R_RR); const bf16_t* KK = (const bf16_t*)(p.ws + R_KK); const bf16_t* VV = (const bf16_t*)(p.ws + R_VV);
    const bf16_t* SW = (const bf16_t*)(p.ws + R_SW) + (size_t)DIR * MPAD * 256; const bf16_t* AA = (const bf16_t*)(p.ws + R_AA) + (size_t)DIR * MPAD * 256;
    unsigned char* ob = (unsigned char*)p.out;
    const float* INV = (const float*)(ob + O_INV);
    bf16_t* YL = (bf16_t*)(ob + O_YL) + (size_t)DIR * MPAD * 256; bf16_t* ZZ = (bf16_t*)(p.ws + R_Z) + (size_t)DIR * MPAD * 256; bf16_t* UU = (bf16_t*)(ob + O_U); bf16_t* PT = (bf16_t*)(ob + O_PT);
    const int g = item >> 3, hd = (item >> 1) & 3;
    int seq, c; chunk_decode(g, seq, c); int t0, t1; chunk_range(c, t0, t1);
    const int base = seq_start(seq), nsub = (t1 - t0) >> 3, ch = hd * 64 + lane;
    const int la = lane >> 2, lb = lane & 3;
    CL[lane] = p.in[16][(size_t)l * 256 + ch]; CL[64 + lane] = p.in[17][(size_t)l * 256 + ch];
    f32x2 SU[4][8], SP[4][8];
#pragma unroll
    for (int ri = 0; ri < 4; ++ri)
#pragma unroll
        for (int cp = 0; cp < 8; ++cp) { SU[ri][cp] = (f32x2){0.f, 0.f}; SP[ri][cp] = (f32x2){(4 * la + ri == 16 * lb + 2 * cp) ? 1.f : 0.f, (4 * la + ri == 16 * lb + 2 * cp + 1) ? 1.f : 0.f}; }
    const int ss = lane >> 3, cg = lane & 7;
#define SCAN_FETCH(sub_) const size_t row_ = (size_t)base + (DIR == 0 ? t0 + 8 * (sub_) + ss : t1 - 1 - 8 * (sub_) - ss); const size_t o_ = row_ * 256 + hd * 64 + 8 * cg; \
        const u32x4 xr = *(const u32x4*)(RR + o_), xk = *(const u32x4*)(KK + o_), xv = *(const u32x4*)(VV + o_), xw = *(const u32x4*)(SW + o_), xa = *(const u32x4*)(AA + o_); const float xi = INV[row_ * 4 + hd]
#define LD4(dst, off_) do { const f32x4 t0_ = *(const LAS f32x4*)(Ls + (off_) + 16 * lb), t1_ = *(const LAS f32x4*)(Ls + (off_) + 16 * lb + 4); \
        dst[0] = (f32x2){t0_[0], t0_[1]}; dst[1] = (f32x2){t0_[2], t0_[3]}; dst[2] = (f32x2){t1_[0], t1_[1]}; dst[3] = (f32x2){t1_[2], t1_[3]}; } while (0)
    for (int sub = 0; sub < nsub; ++sub) {
        const size_t rowb = (size_t)base + (DIR == 0 ? t0 + 8 * sub : t1 - 1 - 8 * sub);
        {
            SCAN_FETCH(sub);
            LAS float* Ls = L + ss * 384 + 8 * cg;
            const f32x4 c0 = *(const LAS f32x4*)(CL + 8 * cg), c1 = *(const LAS f32x4*)(CL + 8 * cg + 4), d0 = *(const LAS f32x4*)(CL + 64 + 8 * cg), d1 = *(const LAS f32x4*)(CL + 64 + 8 * cg + 4);
            f32x4 ow[2], oka[2], okd[2], okk[2], orr[2], ov[2];
#pragma unroll
            for (int e = 0; e < 8; ++e) {
                const float r = (e & 1) ? hi_bf(xr[e >> 1]) : lo_bf(xr[e >> 1]), k = (e & 1) ? hi_bf(xk[e >> 1]) : lo_bf(xk[e >> 1]), v = (e & 1) ? hi_bf(xv[e >> 1]) : lo_bf(xv[e >> 1]);
                const float sw = (e & 1) ? hi_bf(xw[e >> 1]) : lo_bf(xw[e >> 1]), a = (e & 1) ? hi_bf(xa[e >> 1]) : lo_bf(xa[e >> 1]);
                const float k_k = e < 4 ? c0[e & 3] : c1[e & 3], k_a = e < 4 ? d0[e & 3] : d1[e & 3];
                const float kk = k * k_k * xi;
                ow[e >> 2][e & 3] = fexp2(-sw * LOG2E); oka[e >> 2][e & 3] = -kk * a; okd[e >> 2][e & 3] = k * (1.f + (a - 1.f) * k_a); okk[e >> 2][e & 3] = kk; orr[e >> 2][e & 3] = r; ov[e >> 2][e & 3] = v;
            }
            *(LAS f32x4*)(Ls) = ow[0]; *(LAS f32x4*)(Ls + 4) = ow[1]; *(LAS f32x4*)(Ls + 64) = oka[0]; *(LAS f32x4*)(Ls + 68) = oka[1];
            *(LAS f32x4*)(Ls + 128) = okd[0]; *(LAS f32x4*)(Ls + 132) = okd[1]; *(LAS f32x4*)(Ls + 192) = okk[0]; *(LAS f32x4*)(Ls + 196) = okk[1];
            *(LAS f32x4*)(Ls + 256) = orr[0]; *(LAS f32x4*)(Ls + 260) = orr[1]; *(LAS f32x4*)(Ls + 320) = ov[0]; *(LAS f32x4*)(Ls + 324) = ov[1];
        }
        __builtin_amdgcn_fence(__ATOMIC_RELEASE, "wavefront"); __builtin_amdgcn_wave_barrier(); __builtin_amdgcn_fence(__ATOMIC_ACQUIRE, "wavefront");
        bf16_t* py = YL + rowb * 256 + ch; bf16_t* pz = ZZ + rowb * 256 + ch;
#pragma unroll 1
        for (int s = 0; s < 8; ++s) {
            const LAS float* Ls = L + s * 384;
            f32x2 aU[4], aP[4];
#pragma unroll
            for (int hh = 0; hh < 2; ++hh) {
                f32x2 kk_[4]; LD4(kk_, 192 + 8 * hh);
#pragma unroll
                for (int ri = 0; ri < 4; ++ri) {
                    if (hh == 0) { aU[ri] = SU[ri][0] * kk_[0]; aP[ri] = SP[ri][0] * kk_[0]; }
                    else { aU[ri] = __builtin_elementwise_fma(SU[ri][4], kk_[0], aU[ri]); aP[ri] = __builtin_elementwise_fma(SP[ri][4], kk_[0], aP[ri]); }
#pragma unroll
                    for (int c = 1; c < 4; ++c) { aU[ri] = __builtin_elementwise_fma(SU[ri][4 * hh + c], kk_[c], aU[ri]); aP[ri] = __builtin_elementwise_fma(SP[ri][4 * hh + c], kk_[c], aP[ri]); }
                }
            }
            float saU[4], saP[4];
#pragma unroll
            for (int ri = 0; ri < 4; ++ri) { saU[ri] = allsum4(aU[ri][0] + aU[ri][1]); saP[ri] = allsum4(aP[ri][0] + aP[ri][1]); }
            __builtin_amdgcn_sched_barrier(0);
            const f32x4 v4 = *(const LAS f32x4*)(Ls + 320 + 4 * la);
            f32x2 bU[4], bP[4];
#pragma unroll
            for (int ri = 0; ri < 4; ++ri) { bU[ri] = (f32x2){0.f, 0.f}; bP[ri] = (f32x2){0.f, 0.f}; }
#pragma unroll
            for (int hh = 0; hh < 2; ++hh) {
                f32x2 wv_[4], ka_[4], kd_[4], r_[4];
                LD4(wv_, 8 * hh); LD4(ka_, 64 + 8 * hh); LD4(kd_, 128 + 8 * hh); LD4(r_, 256 + 8 * hh);
#pragma unroll
                for (int ri = 0; ri < 4; ++ri) {
                    const f32x2 sU2 = {saU[ri], saU[ri]}, sP2 = {saP[ri], saP[ri]}, v2 = {v4[ri], v4[ri]};
#pragma unroll
                    for (int c = 0; c < 4; ++c) {
                        const int cp = 4 * hh + c;
                        f32x2 u = SU[ri][cp] * wv_[c]; u = __builtin_elementwise_fma(sU2, ka_[c], u); u = __builtin_elementwise_fma(v2, kd_[c], u); SU[ri][cp] = u;
                        f32x2 q = SP[ri][cp] * wv_[c]; q = __builtin_elementwise_fma(sP2, ka_[c], q); SP[ri][cp] = q;
                        bU[ri] = __builtin_elementwise_fma(u, r_[c], bU[ri]); bP[ri] = __builtin_elementwise_fma(q, r_[c], bP[ri]);
                    }
                }
                __builtin_amdgcn_sched_barrier(0);
            }
            float oU = 0.f, oP = 0.f;
#pragma unroll
            for (int ri = 0; ri < 4; ++ri) {
                const float yu = allsum4(bU[ri][0] + bU[ri][1]), yp = allsum4(bP[ri][0] + bP[ri][1]);
                oU = lb == ri ? yu : oU; oP = lb == ri ? yp : oP;
            }
            const int so = DIR == 0 ? s : -s;
            py[so * 256] = f2bf(oU); pz[so * 256] = f2bf(oP);
        }
        __builtin_amdgcn_fence(__ATOMIC_RELEASE, "wavefront"); __builtin_amdgcn_wave_barrier(); __builtin_amdgcn_fence(__ATOMIC_ACQUIRE, "wavefront");
    }
#undef SCAN_FETCH
#undef LD4
#pragma unroll
    for (int ri = 0; ri < 4; ++ri) {
        const size_t o = ((size_t)item * 64 + 4 * la + ri) * 64 + 16 * lb;
#pragma unroll
        for (int hh = 0; hh < 2; ++hh) {
            u32x4 x = {pack2(SU[ri][4 * hh][0], SU[ri][4 * hh][1]), pack2(SU[ri][4 * hh + 1][0], SU[ri][4 * hh + 1][1]), pack2(SU[ri][4 * hh + 2][0], SU[ri][4 * hh + 2][1]), pack2(SU[ri][4 * hh + 3][0], SU[ri][4 * hh + 3][1])};
            u32x4 y = {pack2(SP[ri][4 * hh][0], SP[ri][4 * hh][1]), pack2(SP[ri][4 * hh + 1][0], SP[ri][4 * hh + 1][1]), pack2(SP[ri][4 * hh + 2][0], SP[ri][4 * hh + 2][1]), pack2(SP[ri][4 * hh + 3][0], SP[ri][4 * hh + 3][1])};
            *(u32x4*)(UU + o + 8 * hh) = x; *(u32x4*)(PT + o + 8 * hh) = y;
        }
    }
}
DI void phase_scan(int wv, const Params& p, int l, LAS unsigned char* lds) {
    const int tid = tid_(wv), lane = tid & 63, w = tid >> 6, gw = blockIdx.x * 8 + w, nw = gridDim.x * 8;
    LAS float* L = (LAS float*)(lds + w * 12288); LAS float* CL = (LAS float*)(lds + 98304 + w * 512);
    for (int item = gw; item < NCH * 8; item += nw) {
        if (item & 1) scan_item<1>(p, l, L, CL, item, lane); else scan_item<0>(p, l, L, CL, item, lane);
    }
}

DI void propagate_chain(int wv, const Params& p, int chain, LAS unsigned char* lds) {
    unsigned char* ob = (unsigned char*)p.out;
    bf16_t* UU = (bf16_t*)(ob + O_U); const bf16_t* PT = (const bf16_t*)(ob + O_PT);
    const int seq = chain >> 3, hd = (chain >> 1) & 3, dir = chain & 1;
    const int nch = seq == 0 ? NCP : NCS, gbase = seq == 0 ? 0 : NCP + (seq - 1) * NCS;
    const int tid = tid_(wv), i = tid >> 3, jb = tid & 7;
    LAS float* Ssm = (LAS float*)lds;
    LAS float* Psm = (LAS float*)(lds + 17408);
    float S[8];
#pragma unroll
    for (int e = 0; e < 8; ++e) S[e] = 0.f;
    u32x4 u4, p4;
    { const int c = dir == 0 ? 0 : nch - 1; const size_t item = ((size_t)(gbase + c) * 4 + hd) * 2 + dir;
      u4 = *(const u32x4*)(UU + (item * 64 + i) * 64 + 8 * jb); p4 = *(const u32x4*)(PT + (item * 64 + i) * 64 + 8 * jb); }
    for (int step = 0; step < nch; ++step) {
        const int c = dir == 0 ? step : nch - 1 - step; const size_t item = ((size_t)(gbase + c) * 4 + hd) * 2 + dir;
        bf16_t* up = UU + (item * 64 + i) * 64 + 8 * jb;
        __syncthreads();
#pragma unroll
        for (int e = 0; e < 4; ++e) { Psm[i * 64 + 8 * jb + 2 * e] = lo_bf(p4[e]); Psm[i * 64 + 8 * jb + 2 * e + 1] = hi_bf(p4[e]); }
#pragma unroll
        for (int e = 0; e < 8; ++e) Ssm[i * 68 + 8 * jb + e] = S[e];
        { u32x4 so = {pack2(S[0], S[1]), pack2(S[2], S[3]), pack2(S[4], S[5]), pack2(S[6], S[7])}; *(u32x4*)up = so; }
        __syncthreads();
        float acc[8];
#pragma unroll
        for (int e = 0; e < 4; ++e) { acc[2 * e] = lo_bf(u4[e]); acc[2 * e + 1] = hi_bf(u4[e]); }
        if (step + 1 < nch) {
            const int c2 = dir == 0 ? step + 1 : nch - 2 - step; const size_t item2 = ((size_t)(gbase + c2) * 4 + hd) * 2 + dir;
            u4 = *(const u32x4*)(UU + (item2 * 64 + i) * 64 + 8 * jb); p4 = *(const u32x4*)(PT + (item2 * 64 + i) * 64 + 8 * jb);
        }
#pragma unroll 8
        for (int k = 0; k < 64; ++k) {
            const float sv = Ssm[i * 68 + k];
            const f32x4 a = *(const LAS f32x4*)(Psm + k * 64 + 8 * jb), b = *(const LAS f32x4*)(Psm + k * 64 + 8 * jb + 4);
#pragma unroll
            for (int e = 0; e < 4; ++e) { acc[e] += sv * a[e]; acc[4 + e] += sv * b[e]; }
        }
#pragma unroll
        for (int e = 0; e < 8; ++e) S[e] = acc[e];
    }
    __syncthreads();
}

DI void phase_finalize(int wv, const Params& p, int l, LAS unsigned char* lds) {
    unsigned char* ob = (unsigned char*)p.out;
    const bf16_t* YL = (const bf16_t*)(ob + O_YL); const bf16_t* ZZ = (const bf16_t*)(p.ws + R_Z); const bf16_t* UU = (const bf16_t*)(ob + O_U);
    const float* BON = (const float*)(ob + O_BON);
    const bf16_t* VV = (const bf16_t*)(p.ws + R_VV); const bf16_t* G = (const bf16_t*)(p.ws + R_G); bf16_t* MIX = (bf16_t*)(p.ws + R_MIX);
    const int tid = tid_(wv), lane = tid & 63, w = tid >> 6, hd = w >> 1, half = w & 1;
    LAS float* Ssm = (LAS float*)lds;
    const float* lng = p.in[19] + (size_t)l * 256 + hd * 64; const float* lnb = p.in[20] + (size_t)l * 256 + hd * 64;
    for (int g = blockIdx.x; g < NCH; g += gridDim.x) {
        int seq, c; chunk_decode(g, seq, c); int t0, t1; chunk_range(c, t0, t1);
        const int t = t0 + 64 * half + lane; const bool valid = t < t1; const size_t row = (size_t)seq_start(seq) + (valid ? t : t0);
        float y[64];
#pragma unroll
        for (int i = 0; i < 64; ++i) y[i] = 0.f;
        for (int dir = 0; dir < 2; ++dir) {
            __syncthreads();
            {
                const int h2 = tid >> 7, e0 = (tid & 127) * 32;
                const bf16_t* src = UU + ((((size_t)g * 4 + h2) * 2 + dir) * 4096) + e0;
#pragma unroll
                for (int q = 0; q < 4; ++q) { const u32x4 v = *(const u32x4*)(src + 8 * q);
#pragma unroll
                    for (int e = 0; e < 4; ++e) { Ssm[h2 * 4096 + e0 + 8 * q + 2 * e] = lo_bf(v[e]); Ssm[h2 * 4096 + e0 + 8 * q + 2 * e + 1] = hi_bf(v[e]); } }
            }
            __syncthreads();
            const size_t o = ((size_t)dir * MPAD + row) * 256 + hd * 64;
            f32x2 z[32];
            u32x4 zr[8], yr[8];
#pragma unroll
            for (int q = 0; q < 8; ++q) { zr[q] = *(const u32x4*)(ZZ + o + 8 * q); yr[q] = *(const u32x4*)(YL + o + 8 * q); }
            __builtin_amdgcn_sched_barrier(0);
#pragma unroll
            for (int q = 0; q < 8; ++q) { const u32x4 zv = zr[q], yv = yr[q];
#pragma unroll
                for (int e = 0; e < 4; ++e) { z[4 * q + e] = (f32x2){lo_bf(zv[e]), hi_bf(zv[e])}; y[8 * q + 2 * e] += lo_bf(yv[e]); y[8 * q + 2 * e + 1] += hi_bf(yv[e]); } }
            const LAS float* Sh = Ssm + hd * 4096;
#pragma unroll
            for (int i = 0; i < 64; ++i) {
                f32x2 a0 = {0.f, 0.f}, a1 = {0.f, 0.f};
#pragma unroll
                for (int j = 0; j < 16; ++j) { const f32x4 s4 = *(const LAS f32x4*)(Sh + i * 64 + 4 * j);
                    a0 = __builtin_elementwise_fma((f32x2){s4[0], s4[1]}, z[2 * j], a0); a1 = __builtin_elementwise_fma((f32x2){s4[2], s4[3]}, z[2 * j + 1], a1); }
                y[i] += (a0[0] + a0[1]) + (a1[0] + a1[1]);
            }
        }
        if (valid) {
            float mean = 0.f;
#pragma unroll
            for (int i = 0; i < 64; ++i) mean += y[i];
            mean *= (1.f / 64);
            float var = 0.f;
#pragma unroll
            for (int i = 0; i < 64; ++i) { const float d = y[i] - mean; var += d * d; }
            const float rs = __builtin_amdgcn_rsqf(var * (1.f / 64) + 64e-5f);
            const float bon = BON[row * 4 + hd];
            u32x4 vr[8], gr[8];
#pragma unroll
            for (int q = 0; q < 8; ++q) { vr[q] = *(const u32x4*)(VV + row * 256 + hd * 64 + 8 * q); gr[q] = *(const u32x4*)(G + row * 256 + hd * 64 + 8 * q); }
            __builtin_amdgcn_sched_barrier(0);
#pragma unroll
            for (int q = 0; q < 8; ++q) {
                const u32x4 vv = vr[q], gv = gr[q];
                const f32x4 g0 = *(const f32x4*)(lng + 8 * q), g1 = *(const f32x4*)(lng + 8 * q + 4), b0 = *(const f32x4*)(lnb + 8 * q), b1 = *(const f32x4*)(lnb + 8 * q + 4);
                float o8[8];
#pragma unroll
                for (int e = 0; e < 8; ++e) {
                    const float gn = (y[8 * q + e] - mean) * rs * (e < 4 ? g0[e] : g1[e - 4]) + (e < 4 ? b0[e] : b1[e - 4]);
                    const float ve = (e & 1) ? hi_bf(vv[e >> 1]) : lo_bf(vv[e >> 1]), ge = (e & 1) ? hi_bf(gv[e >> 1]) : lo_bf(gv[e >> 1]);
                    o8[e] = (gn + bon * ve) * ge;
                }
                u32x4 pk = {pack2(o8[0], o8[1]), pack2(o8[2], o8[3]), pack2(o8[4], o8[5]), pack2(o8[6], o8[7])};
                *(u32x4*)(MIX + row * 1024 + hd * 64 + 8 * q) = pk;
            }
        }
    }
    __syncthreads();
}

#define MFMA32(a, b, c) __builtin_amdgcn_mfma_f32_32x32x16_bf16((a), (b), (c), 0, 0, 0)
template <int DQK, bool SWA, bool MASK, class KF, class VF>
DI void attn_subtile(const bf16x8 (&qf)[DQK / 16], f32x16& o0, f32x16& o1, float& lsum, int kbase, int h, int qpos, int T, const LAS float* LUT, KF kfrag, VF vfrag) {
    f32x16 s;
#pragma unroll
    for (int i = 0; i < 16; ++i) s[i] = 0.f;
#pragma unroll
    for (int ks = 0; ks < DQK / 16; ++ks) s = MFMA32(kfrag(ks), qf[ks], s);
    float pv[16];
    if (SWA) {
        float bias[16];
#pragma unroll
        for (int i = 0; i < 16; ++i) {
            const int rel = kbase + (i & 3) + 8 * (i >> 2) + 4 * h - qpos;
            const int idx = rel < -129 ? -129 : (rel > 129 ? 129 : rel); bias[i] = LUT[idx + 129];
        }
#pragma unroll
        for (int i = 0; i < 16; ++i) {
            const int kpos = kbase + (i & 3) + 8 * (i >> 2) + 4 * h, rel = kpos - qpos;
            const float e = fexp2(s[i] + bias[i]);
            const bool vis = kpos < T && (kpos < 16 || (rel <= 128 && rel >= -128));
            pv[i] = vis ? e : 0.f; lsum += pv[i];
        }
    } else {
#pragma unroll
        for (int i = 0; i < 16; ++i) {
            const float e = fexp2(s[i]);
            if (MASK) { const int kpos = kbase + (i & 3) + 8 * (i >> 2) + 4 * h; pv[i] = kpos < T ? e : 0.f; } else pv[i] = e;
            lsum += pv[i];
        }
    }
#pragma unroll
    for (int s2 = 0; s2 < 2; ++s2) {
        u32x4 pk = {pack2(pv[8 * s2], pv[8 * s2 + 1]), pack2(pv[8 * s2 + 2], pv[8 * s2 + 3]), pack2(pv[8 * s2 + 4], pv[8 * s2 + 5]), pack2(pv[8 * s2 + 6], pv[8 * s2 + 7])};
        const bf16x8 pf = __builtin_bit_cast(bf16x8, pk);
        o0 = MFMA32(vfrag(0, s2), pf, o0); o1 = MFMA32(vfrag(1, s2), pf, o1);
    }
}
template <int DQK, bool MASK>
DI void attn_tile64(const bf16x8 (&qf)[DQK / 16], f32x16& o0, f32x16& o1, float& lsum, int kbase0, int r, int h, int T, const LAS unsigned char* Ksm, const LAS unsigned char* Vsm) {
    constexpr int KP = DQK * 2 + 16, NKS = DQK / 16;
    bf16x8 ka[2][NKS];
#pragma unroll
    for (int kt = 0; kt < 2; ++kt)
#pragma unroll
        for (int ks = 0; ks < NKS; ++ks) ka[kt][ks] = *(const LAS bf16x8*)(Ksm + (32 * kt + r) * KP + (16 * ks + 8 * h) * 2);
    f32x16 sa[2];
#pragma unroll
    for (int kt = 0; kt < 2; ++kt)
#pragma unroll
        for (int i = 0; i < 16; ++i) sa[kt][i] = 0.f;
#pragma unroll
    for (int ks = 0; ks < NKS; ++ks)
#pragma unroll
        for (int kt = 0; kt < 2; ++kt) sa[kt] = MFMA32(ka[kt][ks], qf[ks], sa[kt]);
    bf16x8 pf[2][2];
    f32x2 ls2 = {0.f, 0.f};
#pragma unroll
    for (int kt = 0; kt < 2; ++kt) {
        float pv[16];
#pragma unroll
        for (int i = 0; i < 16; ++i) {
            const float sv = sa[kt][i];
            if (MASK) { const int kpos = kbase0 + 32 * kt + (i & 3) + 8 * (i >> 2) + 4 * h; const float e = fexp2(sv); pv[i] = kpos < T ? e : 0.f; } else pv[i] = fexp2(sv);
        }
#pragma unroll
        for (int i = 0; i < 16; i += 2) ls2 = ls2 + (f32x2){pv[i], pv[i + 1]};
#pragma unroll
        for (int s2 = 0; s2 < 2; ++s2) {
            u32x4 pk = {pack2(pv[8 * s2], pv[8 * s2 + 1]), pack2(pv[8 * s2 + 2], pv[8 * s2 + 3]), pack2(pv[8 * s2 + 4], pv[8 * s2 + 5]), pack2(pv[8 * s2 + 6], pv[8 * s2 + 7])};
            pf[kt][s2] = __builtin_bit_cast(bf16x8, pk);
        }
    }
    lsum += ls2[0] + ls2[1];
#pragma unroll
    for (int kt = 0; kt < 2; ++kt)
#pragma unroll
        for (int s2 = 0; s2 < 2; ++s2) {
            { const u32x2 a0 = *(const LAS u32x2*)(Vsm + r * 144 + (32 * kt + 16 * s2 + 4 * h) * 2), a1 = *(const LAS u32x2*)(Vsm + r * 144 + (32 * kt + 16 * s2 + 8 + 4 * h) * 2);
              u32x4 av = {a0[0], a0[1], a1[0], a1[1]}; o0 = MFMA32(__builtin_bit_cast(bf16x8, av), pf[kt][s2], o0); }
            { const u32x2 a0 = *(const LAS u32x2*)(Vsm + (32 + r) * 144 + (32 * kt + 16 * s2 + 4 * h) * 2), a1 = *(const LAS u32x2*)(Vsm + (32 + r) * 144 + (32 * kt + 16 * s2 + 8 + 4 * h) * 2);
              u32x4 av = {a0[0], a0[1], a1[0], a1[1]}; o1 = MFMA32(__builtin_bit_cast(bf16x8, av), pf[kt][s2], o1); }
        }
}
DI void attn_lut(LAS float* LUT, int tid, const float* relb, int qhead) {
    if (tid < 259) { const int rel = tid - 129, n = rel < 0 ? -rel : rel; int b;
        if (n < 8) b = n; else { int m = (31 - __builtin_clz((unsigned)(n * n))) - 6; b = 8 + m; if (b > 15) b = 15; }
        if (rel > 0) b += 16;
        LUT[tid] = relb[b * 8 + qhead] * LOG2E; }
}
constexpr int ATT_BUF = 22528, ATT_LUT = 2 * ATT_BUF, ATT_RED = ATT_LUT + 1280;
template <int DQK, bool SWA>
DI void attn_block(int wv, LAS unsigned char* lds, const bf16_t* Q, int ldq, int qoff, const bf16_t* K, int ldk, int koff, const bf16_t* Vt,
                   int base, int T, int q0, bf16_t* O, int ldo, int ooff, const float* relb, int qhead, float sink_add) {
    constexpr int KP = DQK * 2 + 16, CPR = DQK / 8, NKC = 64 * CPR, NKS = DQK / 16, KSZ = 13312;
    const int tid = tid_(wv), lane = tid & 63, w = tid >> 6, r = lane & 31, h = lane >> 5;
    LAS float* LUT = (LAS float*)(lds + ATT_LUT);
    __syncthreads();
    if (SWA) attn_lut(LUT, tid, relb, qhead);
    const int qw0 = q0 + 32 * w, qpos = qw0 + r; const size_t qrow = (size_t)base + qpos;
    bf16x8 qf[NKS];
#pragma unroll
    for (int ks = 0; ks < NKS; ++ks) qf[ks] = *(const bf16x8*)(Q + qrow * ldq + qoff + 16 * ks + 8 * h);
    f32x16 o0, o1;
#pragma unroll
    for (int i = 0; i < 16; ++i) { o0[i] = 0.f; o1[i] = 0.f; }
    float lsum = 0.f;
    const int nt = (T + 63) >> 6;
    int lo = 0, ntl = nt;
    if (SWA) { lo = (q0 - 128) >> 6; if (lo < 1) lo = 1; int hi = (q0 + 255 + 128) >> 6; if (hi > nt - 1) hi = nt - 1; ntl = 1 + (hi >= lo ? hi - lo + 1 : 0); }
    u32x4 kA0, kA1, vA, kB0, kB1, vB;
    kA1 = (u32x4){0u, 0u, 0u, 0u}; kB1 = kA1;
    const int kc0 = tid, kc1 = tid + 512;
    const int kkey0 = kc0 / CPR, kpart0 = kc0 % CPR, kkey1 = kc1 / CPR, kpart1 = kc1 % CPR;
    const int vd = tid >> 3, vpart = tid & 7;
#define ATT_TILE(it_) (SWA ? ((it_) == 0 ? 0 : lo + (it_) - 1) : (it_))
#define ATT_GLOAD(k0_, k1_, v_, tile) do { const size_t rb = (size_t)base + (size_t)(tile) * 64; \
        k0_ = *(const u32x4*)(K + (rb + kkey0) * ldk + koff + kpart0 * 8); \
        if (kc1 < NKC) k1_ = *(const u32x4*)(K + (rb + kkey1) * ldk + koff + kpart1 * 8); \
        v_ = *(const u32x4*)(Vt + (size_t)vd * MPAD + rb + vpart * 8); } while (0)
#define ATT_LWRITE(k0_, k1_, v_, b) do { LAS unsigned char* kb = lds + (b) * ATT_BUF; \
        *(LAS u32x4*)(kb + kkey0 * KP + kpart0 * 16) = k0_; \
        if (kc1 < NKC) *(LAS u32x4*)(kb + kkey1 * KP + kpart1 * 16) = k1_; \
        *(LAS u32x4*)(kb + KSZ + vd * 144 + vpart * 16) = v_; } while (0)
#define ATT_COMPUTE(it_) do { const int tile = ATT_TILE(it_); \
        const LAS unsigned char* Ksm = lds + ((it_) & 1) * ATT_BUF; const LAS unsigned char* Vsm = Ksm + KSZ; \
        if (!SWA) { \
            if (tile * 64 + 64 > T) attn_tile64<DQK, true>(qf, o0, o1, lsum, tile * 64, r, h, T, Ksm, Vsm); \
            else attn_tile64<DQK, false>(qf, o0, o1, lsum, tile * 64, r, h, T, Ksm, Vsm); \
        } else { \
            _Pragma("unroll") for (int kt = 0; kt < 2; ++kt) { \
                const int kbase = tile * 64 + 32 * kt; \
                const bool need = (kbase < 16) || (kbase + 31 >= qw0 - 128 && kbase <= qw0 + 31 + 128); if (!need) continue; \
                auto kfrag = [&](int ks) { return *(const LAS bf16x8*)(Ksm + (32 * kt + r) * KP + (16 * ks + 8 * h) * 2); }; \
                auto vfrag = [&](int dt, int s2) { const u32x2 a0 = *(const LAS u32x2*)(Vsm + (32 * dt + r) * 144 + (32 * kt + 16 * s2 + 4 * h) * 2), a1 = *(const LAS u32x2*)(Vsm + (32 * dt + r) * 144 + (32 * kt + 16 * s2 + 8 + 4 * h) * 2); \
                                               u32x4 av = {a0[0], a0[1], a1[0], a1[1]}; return __builtin_bit_cast(bf16x8, av); }; \
                attn_subtile<DQK, true, true>(qf, o0, o1, lsum, kbase, h, qpos, T, LUT, kfrag, vfrag); \
            } \
        } } while (0)
    ATT_GLOAD(kA0, kA1, vA, ATT_TILE(0)); ATT_LWRITE(kA0, kA1, vA, 0);
    if (ntl > 1) ATT_GLOAD(kB0, kB1, vB, ATT_TILE(1));
    if (ntl > 2) ATT_GLOAD(kA0, kA1, vA, ATT_TILE(2));
    __syncthreads();
    for (int it = 0; it < ntl; it += 2) {
        if (it + 1 < ntl) ATT_LWRITE(kB0, kB1, vB, 1);
        if (it + 3 < ntl) ATT_GLOAD(kB0, kB1, vB, ATT_TILE(it + 3));
        ATT_COMPUTE(it);
        __syncthreads();
        if (it + 1 < ntl) {
            if (it + 2 < ntl) ATT_LWRITE(kA0, kA1, vA, 0);
            if (it + 4 < ntl) ATT_GLOAD(kA0, kA1, vA, ATT_TILE(it + 4));
            ATT_COMPUTE(it + 1);
            __syncthreads();
        }
    }
#undef ATT_COMPUTE
#undef ATT_GLOAD
#undef ATT_LWRITE
#undef ATT_TILE
    lsum += shx(lsum, lane, 32);
    const float il = 1.f / (lsum + sink_add);
    bf16_t* op = O + ((size_t)base + qpos) * ldo + ooff;
#pragma unroll
    for (int g4 = 0; g4 < 4; ++g4) {
        u32x2 a = {pack2(o0[4 * g4] * il, o0[4 * g4 + 1] * il), pack2(o0[4 * g4 + 2] * il, o0[4 * g4 + 3] * il)};
        u32x2 b = {pack2(o1[4 * g4] * il, o1[4 * g4 + 1] * il), pack2(o1[4 * g4 + 2] * il, o1[4 * g4 + 3] * il)};
        *(u32x2*)(op + 8 * g4 + 4 * h) = a; *(u32x2*)(op + 32 + 8 * g4 + 4 * h) = b;
    }
}
template <int DQK, bool SWA>
DI void attn_tail(int wv, LAS unsigned char* lds, const bf16_t* Q, int ldq, int qoff, const bf16_t* K, int ldk, int koff, const bf16_t* Vt,
                  int base, int T, int q0, bf16_t* O, int ldo, int ooff, const float* relb, int qhead, float sink_add) {
    constexpr int NKS = DQK / 16;
    const int tid = tid_(wv), lane = tid & 63, w = tid >> 6, r = lane & 31, h = lane >> 5;
    LAS float* LUT = (LAS float*)(lds + ATT_LUT); LAS float* RED = (LAS float*)(lds + ATT_RED);
    __syncthreads();
    if (SWA) attn_lut(LUT, tid, relb, qhead);
    for (int e = tid; e < 64 * 33; e += 512) RED[e] = 0.f;
    const int qpos = q0 + r; const bool qvalid = qpos < T; const size_t qrow = (size_t)base + (qvalid ? qpos : T - 1);
    bf16x8 qf[NKS];
#pragma unroll
    for (int ks = 0; ks < NKS; ++ks) qf[ks] = *(const bf16x8*)(Q + qrow * ldq + qoff + 16 * ks + 8 * h);
    f32x16 o0, o1;
#pragma unroll
    for (int i = 0; i < 16; ++i) { o0[i] = 0.f; o1[i] = 0.f; }
    float lsum = 0.f;
    const int nt = (T + 63) >> 6;
    int lo = 0, ntl = nt;
    if (SWA) { lo = (q0 - 128) >> 6; if (lo < 1) lo = 1; int hi = nt - 1; ntl = 1 + (hi >= lo ? hi - lo + 1 : 0); }
    __syncthreads();
    for (int it = w; it < ntl; it += 8) {
        const int tile = SWA ? (it == 0 ? 0 : lo + it - 1) : it;
#pragma unroll
        for (int kt = 0; kt < 2; ++kt) {
            const int kbase = tile * 64 + 32 * kt; const size_t rb = (size_t)base + kbase;
            auto kfrag = [&](int ks) { return *(const bf16x8*)(K + (rb + r) * ldk + koff + 16 * ks + 8 * h); };
            auto vfrag = [&](int dt, int s2) { const bf16_t* vp = Vt + (size_t)(32 * dt + r) * MPAD + rb + 16 * s2 + 4 * h; const u32x2 a0 = *(const u32x2*)vp, a1 = *(const u32x2*)(vp + 8);
                                           u32x4 av = {a0[0], a0[1], a1[0], a1[1]}; return __builtin_bit_cast(bf16x8, av); };
            attn_subtile<DQK, SWA, true>(qf, o0, o1, lsum, kbase, h, qpos, T, LUT, kfrag, vfrag);
        }
    }
#pragma unroll
    for (int i = 0; i < 16; ++i) { atomicAdd((float*)(RED + lane * 33 + i), o0[i]); atomicAdd((float*)(RED + lane * 33 + 16 + i), o1[i]); }
    atomicAdd((float*)(RED + lane * 33 + 32), lsum);
    __syncthreads();
    if (w == 0) {
        float l = RED[lane * 33 + 32]; l += shx(l, lane, 32);
        const float il = 1.f / (l + sink_add);
        if (qvalid) {
            bf16_t* op = O + ((size_t)base + qpos) * ldo + ooff;
#pragma unroll
            for (int g4 = 0; g4 < 4; ++g4) {
                const LAS float* a = RED + lane * 33 + 4 * g4; const LAS float* b = RED + lane * 33 + 16 + 4 * g4;
                u32x2 pa = {pack2(a[0] * il, a[1] * il), pack2(a[2] * il, a[3] * il)}, pb = {pack2(b[0] * il, b[1] * il), pack2(b[2] * il, b[3] * il)};
                *(u32x2*)(op + 8 * g4 + 4 * h) = pa; *(u32x2*)(op + 32 + 8 * g4 + 4 * h) = pb;
            }
        }
    }
}

constexpr int N_CHAIN = NSEQ * 8, N_TAIL = NSEQ * 12, N_MLA = 64 * 4 + 32 * 8 * 4, N_SWA = 64 * 8 + 32 * 8 * 8, N_QITEMS = N_CHAIN + N_TAIL + N_MLA + N_SWA;
DI void phase_queue(int wv, const Params& p, int l, LAS unsigned char* lds) {
    unsigned* ctr = (unsigned*)(p.ws + OFF_CTL) + l * 16;
    LAS int* bc = (LAS int*)(lds + 57344);
    unsigned char* ob = (unsigned char*)p.out;
    bf16_t* MIX = (bf16_t*)(p.ws + R_MIX);
    const bf16_t* QM = (const bf16_t*)(p.ws + R_QM); const bf16_t* KM = (const bf16_t*)(p.ws + R_KM); const bf16_t* VTM = (const bf16_t*)(p.ws + R_VTM);
    const bf16_t* QS = (const bf16_t*)(ob + O_QS); const bf16_t* KS = (const bf16_t*)(ob + O_KS); const bf16_t* VTS = (const bf16_t*)(p.ws + R_VTS);
    for (;;) {
        __syncthreads();
        if (tid_(wv) == 0) *bc = (int)atomicAdd(ctr, 1u);
        __syncthreads();
        int it = *bc;
        if (it >= N_QITEMS) break;
        if (it < N_CHAIN) { propagate_chain(wv, p, it, lds); continue; }
        it -= N_CHAIN;
        if (it < N_TAIL) {
            const int seq = it / 12, hh = it % 12, T = seq_len(seq), q0 = T - 16;
            if (hh < 4) attn_tail<96, false>(wv, lds, QM, 384, hh * 96, KM, 384, hh * 96, VTM + (size_t)hh * 64 * MPAD, seq_start(seq), T, q0, MIX, 1024, 768 + hh * 64, nullptr, 0, 0.f);
            else { const int head = hh - 4; attn_tail<64, true>(wv, lds, QS, 512, head * 64, KS, 128, (head >> 2) * 64, VTS + (size_t)(head >> 2) * 64 * MPAD, seq_start(seq), T, q0, MIX, 1024, 256 + head * 64,
                                                               p.in[3], head, fexp2(p.in[23][(size_t)l * 8 + head] * LOG2E)); }
            continue;
        }
        it -= N_TAIL;
        if (it < N_MLA) {
            int seq, head, qb;
            if (it < 256) { seq = 0; head = it & 3; qb = it >> 2; } else { const int m = it - 256; seq = 1 + (m >> 5); head = m & 3; qb = (m >> 2) & 7; }
            attn_block<96, false>(wv, lds, QM, 384, head * 96, KM, 384, head * 96, VTM + (size_t)head * 64 * MPAD, seq_start(seq), seq_len(seq), qb * 256, MIX, 1024, 768 + head * 64, nullptr, 0, 0.f);
            continue;
        }
        it -= N_MLA;
        {
            int seq, head, qb;
            if (it < 512) { seq = 0; head = it & 7; qb = it >> 3; } else { const int m = it - 512; seq = 1 + (m >> 6); head = m & 7; qb = (m >> 3) & 7; }
            attn_block<64, true>(wv, lds, QS, 512, head * 64, KS, 128, (head >> 2) * 64, VTS + (size_t)(head >> 2) * 64 * MPAD, seq_start(seq), seq_len(seq), qb * 256, MIX, 1024, 256 + head * 64,
                                 p.in[3], head, fexp2(p.in[23][(size_t)l * 8 + head] * LOG2E));
        }
    }
}

#define XB_TMO      128
#define XB_XCNT(j)  (256  + 64 * (j))
#define XB_XSUB(j)  (1280 + 64 * (j))
#define XB_XGEN(j)  (2304 + 64 * (j))
#define XB_TOP      3328
#define XB_TOPGEN   3392
#define XB_SPIN_CAP (1u << 18)
DI unsigned xb_ld(unsigned* p)              { return __hip_atomic_load(p, __ATOMIC_RELAXED, __HIP_MEMORY_SCOPE_AGENT); }
DI unsigned xb_add(unsigned* p, unsigned v) { return __hip_atomic_fetch_add(p, v, __ATOMIC_RELAXED, __HIP_MEMORY_SCOPE_AGENT); }
DI unsigned xb_xcc_id() { return (unsigned)__builtin_amdgcn_s_getreg((3 << 11) | 20) & 0xFu; }
#define XB_SPIN(cond, bar) do { unsigned _sp = 0; while (cond) { __builtin_amdgcn_s_sleep(1); \
    if ((++_sp & 255u) == 0u) { if (xb_ld(&(bar)[XB_TMO])) break; if (_sp > XB_SPIN_CAP) { atomicAdd(&(bar)[XB_TMO], 1u); break; } } } } while (0)
struct XcdBarrier { unsigned* bar; unsigned x; volatile LAS unsigned* st; };
DI void xcd_barrier_complete(unsigned* bar, unsigned x, unsigned& nloc, unsigned& nx) {
    const unsigned G = gridDim.x;
    unsigned sum, cnt, mine, sp = 0u;
    for (;;) {
        sum = 0u; cnt = 0u; mine = 0u;
#pragma unroll
        for (unsigned j = 0; j < 16; ++j) { const unsigned c = xb_ld(&bar[XB_XCNT(j)]); sum += c; cnt += (c > 0u) ? 1u : 0u; mine = (j == x) ? c : mine; }
        if (sum == G) break;
        __builtin_amdgcn_s_sleep(1);
        if ((++sp & 255u) == 0u) { if (xb_ld(&bar[XB_TMO])) break; if (sp > XB_SPIN_CAP) { atomicAdd(&bar[XB_TMO], 1u); break; } }
    }
    nloc = mine > 0u ? mine : 1u; nx = cnt > 0u ? cnt : 1u;
}
DI void xcd_barrier(const XcdBarrier& b, int wv) {
    asm volatile("s_waitcnt vmcnt(0)" ::: "memory");
    __syncthreads();
    if (tid_(wv) == 0) {
        unsigned* bar = b.bar;
        __builtin_amdgcn_s_waitcnt(0);
        unsigned nloc = b.st[0], nx = b.st[1];
        if (nloc == 0u) { xcd_barrier_complete(bar, b.x, nloc, nx); b.st[0] = nloc; b.st[1] = nx; }
        const unsigned old = xb_add(&bar[XB_XSUB(b.x)], 1u);
        const unsigned gen = old / nloc;
        if (old + 1u == (gen + 1u) * nloc) {
            __builtin_amdgcn_fence(__ATOMIC_RELEASE, "agent");
            asm volatile("s_waitcnt vmcnt(0)" ::: "memory");
            const unsigned og = xb_add(&bar[XB_TOP], 1u);
            const unsigned tg = og / nx;
            if (og + 1u == (tg + 1u) * nx) xb_add(&bar[XB_TOPGEN], 1u);
            else XB_SPIN(xb_ld(&bar[XB_TOPGEN]) == tg, bar);
            __builtin_amdgcn_fence(__ATOMIC_ACQUIRE, "agent");
            xb_add(&bar[XB_XGEN(b.x)], 1u);
            asm volatile("s_waitcnt vmcnt(0)" ::: "memory");
        } else {
            XB_SPIN(xb_ld(&bar[XB_XGEN(b.x)]) == gen, bar);
            __builtin_amdgcn_fence(__ATOMIC_ACQUIRE, "agent");
            asm volatile("s_waitcnt vmcnt(0)" ::: "memory");
        }
    }
    __syncthreads();
}

template <int l> DI void layer_body(int wv, const Params& p, LAS unsigned char* lds, const XcdBarrier& xb) {
    unsigned char* ob = (unsigned char*)p.out;
    float* H = (float*)(p.ws + OFF_H);
    bf16_t* XN = (bf16_t*)(ob + O_XN);
    bf16_t* ACT = (bf16_t*)(p.ws + R_ACT);
    const bf16_t* W = (const bf16_t*)(p.ws + OFF_W) + (size_t)l * W_LAYER;
    run_gemm(wv, lds, XN, W + W_GU, MPAD, 5632, 1024, EpiSwiglu{ACT});
    xcd_barrier(xb, wv);
    float* SS1 = (float*)(p.ws + OFF_SS1); float* SS2 = (float*)(p.ws + OFF_SS2);
    run_gemm(wv, lds, ACT, W + W_D, MPAD, 1024, 2816, EpiRes{H, 0.5f});
    if (l == 0 && (int)blockIdx.x >= 12) phase_weights(wv, p, 0, J_GU2, J_COUNT, (int)gridDim.x - 12, (int)blockIdx.x - 12);
    xcd_barrier(xb, wv);
    phase_norm<1>(wv, p, p.in[8] + (size_t)l * D, nullptr, false);
    xcd_barrier(xb, wv);
    run_gemm(wv, lds, XN, W + W_IN, MPAD, 2304, 1024, EpiSt<0>{(bf16_t*)(p.ws + R_P), (size_t)PLD, 2304});
    run_gemm(wv, lds, W + W_VS, XN, 256, MPAD, 1024, EpiSt<0>{(bf16_t*)(p.ws + R_VTS), (size_t)MPAD, MPAD});
    xcd_barrier(xb, wv);
    phase_prep1(wv, p, l);
    xcd_barrier(xb, wv);
    run_gemm(wv, lds, (const bf16_t*)(ob + O_ASM), W + W_LR, MPAD, 1280, 256,
             EpiLr{(bf16_t*)(p.ws + R_SW), (bf16_t*)(p.ws + R_AA), (bf16_t*)(p.ws + R_G), p.in[11] + (size_t)l * 512, p.in[13] + (size_t)l * 512});
    run_gemm(wv, lds, (const bf16_t*)(ob + O_QA), W + W_QB, MPAD, 512, 256, EpiSt<0>{(bf16_t*)(p.ws + R_QM), (size_t)384, 384});
    run_gemm(wv, lds, (const bf16_t*)(ob + O_KVA), W + W_KN, MPAD, 256, 256, EpiSt<1>{(bf16_t*)(p.ws + R_KM), (size_t)384, 256});
    run_gemm(wv, lds, W + W_KV, (const bf16_t*)(ob + O_KVA), 256, MPAD, 256, EpiSt<0>{(bf16_t*)(p.ws + R_VTM), (size_t)MPAD, MPAD});
    xcd_barrier(xb, wv);
    phase_prep2(wv, p, l);
    phase_scan(wv, p, l, lds);
    xcd_barrier(xb, wv);
    phase_queue(wv, p, l, lds);
    xcd_barrier(xb, wv);
    phase_finalize(wv, p, l, lds);
    xcd_barrier(xb, wv);
    run_gemm(wv, lds, (const bf16_t*)(p.ws + R_MIX), W + W_OUT, MPAD, 1024, 1024, EpiRes{H, 1.0f});
    if (l == 0 && (int)blockIdx.x >= 12) phase_weights(wv, p, 1, J_GU1, J_GU2, (int)gridDim.x - 12, (int)blockIdx.x - 12);
    xcd_barrier(xb, wv);
    phase_norm<1>(wv, p, p.in[31] + (size_t)l * D, nullptr, false);
    xcd_barrier(xb, wv);
    run_gemm(wv, lds, XN, W + W_GU2, MPAD, 5632, 1024, EpiSwiglu{ACT});
    xcd_barrier(xb, wv);
    run_gemm(wv, lds, ACT, W + W_D2, MPAD, 1024, 2816, EpiRes{H, 0.5f});
    if (l == 0 && (int)blockIdx.x >= 12) phase_weights(wv, p, 1, J_GU2, J_COUNT, (int)gridDim.x - 12, (int)blockIdx.x - 12);
    xcd_barrier(xb, wv);
    phase_norm<2>(wv, p, p.in[4] + (size_t)(l < 1 ? l + 1 : 0) * D, p.in[35] + (size_t)l * D, l == 1);
}
__global__ void __launch_bounds__(512, 2) hybrid_fwd(Params p) {
    extern __shared__ __attribute__((aligned(16))) unsigned char shm[];
    LAS unsigned char* lds = (LAS unsigned char*)shm;
    cg::grid_group grid = cg::this_grid();
    const int wv = __builtin_amdgcn_readfirstlane((int)threadIdx.x >> 6);
    volatile LAS unsigned* st = (volatile LAS unsigned*)(lds + 131072 + 64);
    if (threadIdx.x == 0) { st[0] = 0u; st[1] = 0u; }
    __syncthreads();
    XcdBarrier xb; xb.bar = (unsigned*)(p.ws + OFF_CTL + 8192); xb.x = xb_xcc_id(); xb.st = st;
    if (threadIdx.x == 0) (void)xb_add(&xb.bar[XB_XCNT(xb.x)], 1u);
    phase_weights(wv, p, 0, J_GU1, J_GU2, (int)gridDim.x, (int)blockIdx.x);
    phase_norm<0>(wv, p, p.in[4], nullptr, false);
    grid.sync();
    layer_body<0>(wv, p, lds, xb);
    xcd_barrier(xb, wv);
    layer_body<1>(wv, p, lds, xb);
}

extern "C" void kernel_launch(void* const* d_in, const int* in_sizes, int n_in, void* d_out, int out_size, void* d_ws, size_t ws_size, hipStream_t stream) {
    static int grid_blocks = 0;
    if (!grid_blocks) {
        int dev = 0, cus = 0, per_cu = 0;
        hipGetDevice(&dev);
        hipDeviceGetAttribute(&cus, hipDeviceAttributeMultiprocessorCount, dev);
        if (hipFuncSetAttribute((const void*)hybrid_fwd, hipFuncAttributeMaxDynamicSharedMemorySize, LDS_BYTES) != hipSuccess) fprintf(stderr, "hipFuncSetAttribute failed\n");
        hipOccupancyMaxActiveBlocksPerMultiprocessor(&per_cu, (const void*)hybrid_fwd, 512, LDS_BYTES);
        if (per_cu < 1) per_cu = 1;
        grid_blocks = cus * per_cu;
        if (grid_blocks > 256) grid_blocks = 256;
        if (ws_size < WS_NEED || n_in != 36) fprintf(stderr, "kernel_launch: unexpected ws_size %zu (need %zu) or n_in %d\n", ws_size, (size_t)WS_NEED, n_in);
    }
    Params p{};
    for (int i = 0; i < 36; ++i) p.in[i] = (const float*)d_in[i];
    p.out = (float*)d_out; p.ws = (unsigned char*)d_ws;
    hipMemsetAsync((unsigned char*)d_ws + OFF_CTL, 0, CTL_BYTES, stream);
    void* args[] = {&p};
    hipError_t e = hipLaunchCooperativeKernel((const void*)hybrid_fwd, dim3(grid_blocks), dim3(512), args, LDS_BYTES, stream);
    if (e != hipSuccess) fprintf(stderr, "cooperative launch failed: %s (grid %d)\n", hipGetErrorString(e), grid_blocks);
}
```

```cpp
#include <hip/hip_runtime.h>
#include <hip/hip_cooperative_groups.h>
#include <cstdio>
namespace cg = cooperative_groups;

#define DI __device__ __forceinline__
#define LAS __attribute__((address_space(3)))
typedef unsigned short bf16_t;
typedef short bf16x8 __attribute__((ext_vector_type(8)));
typedef short s16x4 __attribute__((ext_vector_type(4)));
typedef float f32x2 __attribute__((ext_vector_type(2)));
typedef float f32x4 __attribute__((ext_vector_type(4)));
typedef float f32x16 __attribute__((ext_vector_type(16)));
typedef unsigned u32x2 __attribute__((ext_vector_type(2)));
typedef unsigned u32x4 __attribute__((ext_vector_type(4)));
typedef __bf16 bf16v2 __attribute__((ext_vector_type(2)));

constexpr int D = 1024, DFF = 2816, NSEQ = 33, TP = 16400, TS = 2064, MTOK = 82448, MPAD = 82688;
constexpr int NCP = 129, NCS = 17, NCH = NCP + 32 * NCS;
constexpr float EPS = 1e-6f, LOG2E = 1.4426950408889634f;
constexpr int PLD = 2304;
constexpr size_t U1 = (size_t)MPAD * 256 * 2;
constexpr size_t OFF_H = 0;
constexpr size_t OFF_W = 8 * U1;
constexpr size_t W_GU = 0, W_D = W_GU + (size_t)5632 * 1024, W_GU2 = W_D + (size_t)1024 * 2816, W_D2 = W_GU2 + (size_t)5632 * 1024,
                 W_IN = W_D2 + (size_t)1024 * 2816, W_VS = W_IN + (size_t)2304 * 1024, W_LR = W_VS + (size_t)256 * 1024, W_QB = W_LR + (size_t)1280 * 256,
                 W_KN = W_QB + (size_t)512 * 256, W_KV = W_KN + (size_t)256 * 256, W_OUT = W_KV + (size_t)256 * 256, W_LAYER = W_OUT + (size_t)1024 * 1024;
constexpr size_t OFF_CTL = OFF_W + 2 * W_LAYER * 2;
constexpr size_t CTL_BYTES = 32768;
constexpr size_t OFF_R = OFF_CTL + CTL_BYTES;
constexpr size_t OFF_SS1 = OFF_R + 15 * U1, OFF_SS2 = OFF_SS1 + (size_t)MPAD * 64;
constexpr size_t WS_NEED = OFF_SS2 + (size_t)MPAD * 64;
static_assert(WS_NEED <= (size_t)1073741824, "workspace plan exceeds 1 GiB");
static_assert(OFF_R % 256 == 0 && OFF_W % 256 == 0, "align");
constexpr size_t R_ACT = OFF_R, R_P = OFF_R, R_VTS = OFF_R + 9 * U1, R_RR = OFF_R + 10 * U1, R_KK = OFF_R + 11 * U1, R_VV = OFF_R + 12 * U1,
                 R_SW = OFF_R, R_AA = OFF_R + 2 * U1, R_G = OFF_R + 4 * U1, R_QM = OFF_R + 5 * U1, R_KM = OFF_R + 5 * U1 + U1 * 3 / 2, R_VTM = OFF_R + 8 * U1,
                 R_Z = OFF_R + 13 * U1, R_MIX = OFF_R;
constexpr size_t O_XN = 0, O_QS = 0, O_KS = 2 * U1, O_ASM = U1 * 5 / 2, O_QA = U1 * 7 / 2, O_KVA = U1 * 9 / 2,
                 O_YL = U1 * 5 / 2, O_U = U1 * 9 / 2, O_PT = O_U + (size_t)NCH * 8 * 8192, O_INV = O_PT + (size_t)NCH * 8 * 8192,
                 O_BON = O_INV + (size_t)MPAD * 16, O_KR = O_BON + (size_t)MPAD * 16, O_END = O_KR + (size_t)MPAD * 64;
static_assert(O_END <= (size_t)82432 * 1024 * 4, "d_out scratch plan too big");
static_assert(O_U % 16 == 0 && O_PT % 16 == 0 && O_INV % 16 == 0 && O_KR % 16 == 0, "align");
constexpr int LDS_BYTES = 132096;

struct Params { const float* in[36]; float* out; unsigned char* ws; };

DI int tid_(int wv) {
    int ln = __builtin_amdgcn_mbcnt_hi(~0u, __builtin_amdgcn_mbcnt_lo(~0u, 0u)); asm volatile("" : "+v"(ln)); return wv * 64 + ln; }
DI float bf2f(bf16_t b) { return __uint_as_float(((unsigned)b) << 16); }
DI unsigned pack2(float lo, float hi) { f32x2 v = {lo, hi}; bf16v2 r = __builtin_convertvector(v, bf16v2); return __builtin_bit_cast(unsigned, r); }
DI bf16_t f2bf(float f) { return (bf16_t)(pack2(f, 0.f) & 0xffffu); }
DI float lo_bf(unsigned u) { return __uint_as_float(u << 16); }
DI float hi_bf(unsigned u) { return __uint_as_float(u & 0xffff0000u); }
DI float fexp2(float x) { return __builtin_amdgcn_exp2f(x); }
DI float frcp(float x) { return __builtin_amdgcn_rcpf(x); }
DI float sigmoidf_(float x) { return frcp(1.f + fexp2(-x * LOG2E)); }
DI int seq_start(int s) { return s == 0 ? 0 : TP + (s - 1) * TS; }
DI int seq_len(int s) { return s == 0 ? TP : TS; }
DI int row_seq(int row) { return row < TP ? 0 : 1 + (row - TP) / TS; }
DI float shx(float v, int lane, int o) { return __int_as_float(__builtin_amdgcn_ds_bpermute((lane ^ o) << 2, __float_as_int(v))); }
template <int W> DI float xsum_(float v, int lane) {
#pragma unroll
    for (int o = 1; o < W; o <<= 1) v += shx(v, lane, o);
    return v;
}

namespace pg8 {
constexpr int BM = 256, BK = 64, HALF = 128, HTB = HALF * BK * 2, STAGE_BYTES = 8 * HTB, NXCD = 8, WGM = 8;
DI int lds_byte(int r, int c) { const int st = (r >> 4) * 2 + (c >> 5), rr = r & 15, cc = c & 31, ob = rr * 64 + cc * 2; return st * 1024 + (ob ^ (((ob >> 9) & 1) << 5)); }
DI void stage_rc(int b, int& R, int& C) { const int st = b / 1024, sb = b % 1024, swz = sb ^ (((sb >> 9) & 1) << 5); R = (st >> 1) * 16 + swz / 64; C = (st & 1) * 32 + (swz % 64) / 2; }
DI int perm32(int rho) { const int n = rho >> 4, i = rho & 15; return 8 * (i >> 2) + 4 * n + (i & 3); }
struct Unit { int pm, pn; };
struct Gemm { const bf16_t* A; const bf16_t* Bt; int M, N, K; };
struct StaticOrder {
    int nM, nN, nwg, G, c;
    DI void init(int M, int N, int G_, int c_) { nM = M / BM; nN = N / BM; nwg = nM * nN; G = G_; c = c_; }
    DI bool next(int i, Unit& u) const {
        const long L = (long)i * G + c; if (L >= nwg) return false;
        int wgid = (int)L; { const int q = nwg / NXCD, r = nwg % NXCD, xcd = wgid % NXCD, off = wgid / NXCD; wgid = (xcd < r ? xcd * (q + 1) : r * (q + 1) + (xcd - r) * q) + off; }
        const int nig = WGM * nN, gid = wgid / nig, fm = gid * WGM, gsz = (nM - fm) < WGM ? (nM - fm) : WGM;
        u.pm = fm + ((wgid % nig) % gsz); u.pn = (wgid % nig) / gsz; return true;
    }
};
template <class Epi>
DI void gemm_phase(int wv, LAS unsigned char* lds, const Gemm g, const StaticOrder& S, const Epi& E) {
    const int tid = tid_(wv), wid = __builtin_amdgcn_readfirstlane(tid >> 6), lane = tid & 63, wr = wid >> 2, wc = wid & 3, fr = lane & 15, fq = lane >> 4;
    const int K = g.K, nt = K / BK;
    unsigned voffA[2], voffB[2];
#pragma unroll
    for (int i = 0; i < 2; ++i) { int R, C; stage_rc(tid * 16 + i * 8192, R, C); const int Rb = Epi::PERM ? ((R & ~31) + perm32(R & 31)) : R; voffA[i] = (unsigned)(R * K + C) * 2u; voffB[i] = (unsigned)(Rb * K + C) * 2u; }
    const size_t kstep = (size_t)(BK * 2);
    const size_t hstep = (size_t)HALF * K * 2;
    const size_t tstep = 2 * hstep;
    const unsigned ldsw = (unsigned)wid * 1024u;
    const int aoff = lds_byte(wr * 64 + fr, fq * 8), boff = lds_byte(wc * 32 + fr, fq * 8);
#define PG8_SA(b, h) (((b) * 2 + (h)) * HTB)
#define PG8_SB(b, h) ((4 + (b) * 2 + (h)) * HTB)
#define PG8_STAGE(bufoff, gbase, voff) do { _Pragma("unroll") for (int _i = 0; _i < 2; ++_i) \
        __builtin_amdgcn_global_load_lds((const unsigned*)((const char*)(gbase) + (voff)[_i]), (LAS unsigned*)(lds + (bufoff) + ldsw + _i * 8192), 16, 0, 0); } while (0)
#define PG8_LDA(dst, b, h) do { _Pragma("unroll") for (int m = 0; m < 4; ++m) _Pragma("unroll") for (int k = 0; k < 2; ++k) dst[m][k] = *(const LAS bf16x8*)(lds + PG8_SA(b, h) + aoff + m * 2048 + k * 1024); } while (0)
#define PG8_LDB(dst, b, h) do { _Pragma("unroll") for (int n = 0; n < 2; ++n) _Pragma("unroll") for (int k = 0; k < 2; ++k) dst[n][k] = *(const LAS bf16x8*)(lds + PG8_SB(b, h) + boff + n * 2048 + k * 1024); } while (0)
#define PG8_MMA(ai, bj, At, Bt) do { __builtin_amdgcn_s_setprio(1); _Pragma("unroll") for (int m = 0; m < 4; ++m) _Pragma("unroll") for (int n = 0; n < 2; ++n) _Pragma("unroll") for (int k = 0; k < 2; ++k) \
        acc[ai][bj][m][n] = __builtin_amdgcn_mfma_f32_16x16x32_bf16(Bt[n][k], At[m][k], acc[ai][bj][m][n], 0, 0, 0); __builtin_amdgcn_s_setprio(0); } while (0)
#define PG8_WAIT_V(n) asm volatile("s_waitcnt vmcnt(" #n ")" ::: "memory")
#define PG8_WAIT_L(n) asm volatile("s_waitcnt lgkmcnt(" #n ")" ::: "memory")
#define PG8_BAR __builtin_amdgcn_s_barrier()
#define PG8_SCHED __builtin_amdgcn_sched_barrier(0)
    Unit cur, nxt; int ui = 0;
    if (!S.next(0, cur)) return;
    f32x4 acc[2][2][4][2];
#pragma unroll
    for (int a = 0; a < 2; ++a)
#pragma unroll
        for (int b = 0; b < 2; ++b)
#pragma unroll
            for (int m = 0; m < 4; ++m)
#pragma unroll
                for (int n = 0; n < 2; ++n) acc[a][b][m][n] = (f32x4){0.f, 0.f, 0.f, 0.f};
    bf16x8 At[4][2], B0[2][2], B1[2][2];
    const char* cA = (const char*)g.A + (size_t)cur.pm * tstep; const char* cB = (const char*)g.Bt + (size_t)cur.pn * tstep;
    PG8_STAGE(PG8_SB(0, 0), cB, voffB); PG8_STAGE(PG8_SA(0, 0), cA, voffA); PG8_STAGE(PG8_SB(0, 1), cB + hstep, voffB); PG8_STAGE(PG8_SA(0, 1), cA + hstep, voffA);
    if (wr == 1) PG8_BAR;
    PG8_WAIT_V(4); PG8_BAR;
    PG8_STAGE(PG8_SB(1, 0), cB + kstep, voffB); PG8_STAGE(PG8_SA(1, 0), cA + kstep, voffA); PG8_STAGE(PG8_SB(1, 1), cB + hstep + kstep, voffB);
    PG8_WAIT_V(6); PG8_BAR;
    for (;;) {
        const bool has_next = S.next(ui + 1, nxt);
        const char* nA = has_next ? (const char*)g.A + (size_t)nxt.pm * tstep : cA; const char* nB = has_next ? (const char*)g.Bt + (size_t)nxt.pn * tstep : cB;
        for (int t = 0; t < nt; t += 2) {
            const bool last = (t == nt - 2);
            const char* a1 = cA + (size_t)(t + 1) * kstep;
            const char* a2 = last ? nA : cA + (size_t)(t + 2) * kstep; const char* b2 = last ? nB : cB + (size_t)(t + 2) * kstep;
            const char* a3 = a2 + kstep; const char* b3 = b2 + kstep;
            PG8_LDB(B0, 0, 0); PG8_SCHED; PG8_LDA(At, 0, 0); PG8_STAGE(PG8_SA(1, 1), a1 + hstep, voffA);
            PG8_WAIT_L(8); PG8_BAR; PG8_WAIT_L(0); PG8_MMA(0, 0, At, B0); PG8_BAR; PG8_SCHED;
            PG8_LDB(B1, 0, 1); PG8_STAGE(PG8_SB(0, 0), b2, voffB);
            PG8_BAR; PG8_WAIT_L(0); PG8_MMA(0, 1, At, B1); PG8_BAR;
            PG8_LDA(At, 0, 1); PG8_STAGE(PG8_SA(0, 0), a2, voffA);
            PG8_BAR; PG8_WAIT_L(0); PG8_MMA(1, 0, At, B0); PG8_BAR; PG8_SCHED;
            PG8_STAGE(PG8_SB(0, 1), b2 + hstep, voffB);
            PG8_WAIT_V(6); PG8_BAR; PG8_MMA(1, 1, At, B1); PG8_BAR;
            PG8_LDB(B0, 1, 0); PG8_SCHED; PG8_LDA(At, 1, 0); PG8_STAGE(PG8_SA(0, 1), a2 + hstep, voffA);
            PG8_WAIT_L(8); PG8_BAR; PG8_WAIT_L(0); PG8_MMA(0, 0, At, B0); PG8_BAR; PG8_SCHED;
            PG8_LDB(B1, 1, 1); PG8_STAGE(PG8_SB(1, 0), b3, voffB);
            PG8_BAR; PG8_WAIT_L(0); PG8_MMA(0, 1, At, B1); PG8_BAR;
            PG8_LDA(At, 1, 1); PG8_STAGE(PG8_SA(1, 0), a3, voffA);
            PG8_BAR; PG8_WAIT_L(0); PG8_MMA(1, 0, At, B0); PG8_BAR; PG8_SCHED;
            PG8_STAGE(PG8_SB(1, 1), b3 + hstep, voffB);
            PG8_WAIT_V(6); PG8_BAR; PG8_MMA(1, 1, At, B1); PG8_BAR;
        }
        E(acc, cur, wr, wc, fr, fq);
        if (!has_next) break;
#pragma unroll
        for (int a = 0; a < 2; ++a)
#pragma unroll
            for (int b = 0; b < 2; ++b)
#pragma unroll
                for (int m = 0; m < 4; ++m)
#pragma unroll
                    for (int n = 0; n < 2; ++n) acc[a][b][m][n] = (f32x4){0.f, 0.f, 0.f, 0.f};
        cur = nxt; cA = nA; cB = nB; ++ui;
    }
    PG8_WAIT_V(0);
    if (wr == 0) PG8_BAR;
    PG8_BAR;
#undef PG8_SA
#undef PG8_SB
#undef PG8_STAGE
#undef PG8_LDA
#undef PG8_LDB
#undef PG8_MMA
#undef PG8_WAIT_V
#undef PG8_WAIT_L
#undef PG8_BAR
#undef PG8_SCHED
}
}
using pg8::Unit;
typedef f32x4 AccT[2][2][4][2];

struct EpiSwiglu {
    static constexpr bool PERM = true;
    bf16_t* O;
    DI void operator()(const AccT& acc, const Unit& u, int wr, int wc, int fr, int fq) const {
#pragma unroll
        for (int ai = 0; ai < 2; ++ai)
#pragma unroll
            for (int m = 0; m < 4; ++m) {
                const size_t row = (size_t)u.pm * 256 + ai * 128 + wr * 64 + m * 16 + fr;
                float o[8];
#pragma unroll
                for (int n = 0; n < 2; ++n) {
                    const f32x4 g = acc[ai][0][m][n], up = acc[ai][1][m][n];
#pragma unroll
                    for (int e = 0; e < 4; ++e) o[4 * n + e] = g[e] * sigmoidf_(g[e]) * up[e];
                }
                u32x4 pk = {pack2(o[0], o[1]), pack2(o[2], o[3]), pack2(o[4], o[5]), pack2(o[6], o[7])};
                *(u32x4*)(O + row * DFF + u.pn * 128 + wc * 32 + 8 * fq) = pk;
            }
    }
};
struct EpiRes {
    static constexpr bool PERM = false;
    float* H; float alpha;
    DI void operator()(const AccT& acc, const Unit& u, int wr, int wc, int fr, int fq) const {
#pragma unroll
        for (int ai = 0; ai < 2; ++ai) {
            f32x4 h[4][2][2];
            float* base = H + ((size_t)u.pm * 256 + ai * 128 + wr * 64 + fr) * 1024 + u.pn * 256 + wc * 32 + 4 * fq;
#pragma unroll
            for (int m = 0; m < 4; ++m)
#pragma unroll
                for (int bj = 0; bj < 2; ++bj)
#pragma unroll
                    for (int n = 0; n < 2; ++n) h[m][bj][n] = *(const f32x4*)(base + (size_t)m * 16 * 1024 + bj * 128 + n * 16);
            __builtin_amdgcn_sched_barrier(0);
#pragma unroll
            for (int m = 0; m < 4; ++m)
#pragma unroll
                for (int bj = 0; bj < 2; ++bj)
#pragma unroll
                    for (int n = 0; n < 2; ++n) *(f32x4*)(base + (size_t)m * 16 * 1024 + bj * 128 + n * 16) = h[m][bj][n] + acc[ai][bj][m][n] * alpha;
        }
    }
};
template <int MODE> struct EpiSt {
    static constexpr bool PERM = true;
    bf16_t* O; size_t ld; int ncols;
    DI void operator()(const AccT& acc, const Unit& u, int wr, int wc, int fr, int fq) const {
#pragma unroll
        for (int ai = 0; ai < 2; ++ai)
#pragma unroll
            for (int m = 0; m < 4; ++m) {
                const size_t row = (size_t)u.pm * 256 + ai * 128 + wr * 64 + m * 16 + fr;
#pragma unroll
                for (int bj = 0; bj < 2; ++bj) {
                    const int col = u.pn * 256 + bj * 128 + wc * 32 + 8 * fq;
                    if (col < ncols) {
                        const int oc = MODE == 1 ? (col >> 6) * 96 + (col & 63) : col;
                        const f32x4 v0 = acc[ai][bj][m][0], v1 = acc[ai][bj][m][1];
                        u32x4 pk = {pack2(v0[0], v0[1]), pack2(v0[2], v0[3]), pack2(v1[0], v1[1]), pack2(v1[2], v1[3])};
                        *(u32x4*)(O + row * ld + oc) = pk;
                    }
                }
            }
    }
};
struct EpiLr {
    static constexpr bool PERM = true;
    bf16_t *SW, *AA, *G; const float *w0, *a0;
    DI void operator()(const AccT& acc, const Unit& u, int wr, int wc, int fr, int fq) const {
        const int kind = u.pn >> 1, d = u.pn & 1;
        const float* bias = kind == 0 ? w0 + d * 256 : a0 + d * 256;
        bf16_t* dst0 = kind == 0 ? SW + (size_t)d * MPAD * 256 : (kind == 1 ? AA + (size_t)d * MPAD * 256 : G);
        const float sc = kind == 0 ? 0.6065306597126334f : 1.0f;
#pragma unroll
        for (int bj = 0; bj < 2; ++bj) {
            const int c = bj * 128 + wc * 32 + 8 * fq;
            f32x4 b0 = {0.f, 0.f, 0.f, 0.f}, b1 = b0;
            if (kind < 2) { b0 = *(const f32x4*)(bias + c); b1 = *(const f32x4*)(bias + c + 4); }
#pragma unroll
            for (int ai = 0; ai < 2; ++ai)
#pragma unroll
                for (int m = 0; m < 4; ++m) {
                    const size_t row = (size_t)u.pm * 256 + ai * 128 + wr * 64 + m * 16 + fr;
                    const f32x4 v0 = acc[ai][bj][m][0], v1 = acc[ai][bj][m][1];
                    float o[8];
#pragma unroll
                    for (int e = 0; e < 4; ++e) { o[e] = kind < 2 ? sc * sigmoidf_(v0[e] + b0[e]) : v0[e]; o[4 + e] = kind < 2 ? sc * sigmoidf_(v1[e] + b1[e]) : v1[e]; }
                    u32x4 pk = {pack2(o[0], o[1]), pack2(o[2], o[3]), pack2(o[4], o[5]), pack2(o[6], o[7])};
                    *(u32x4*)(dst0 + row * 256 + c) = pk;
                }
        }
    }
};
template <class Epi> DI void run_gemm(int wv, LAS unsigned char* lds, const bf16_t* A, const bf16_t* Bt, int M, int N, int K, const Epi& E) {
    pg8::Gemm g{A, Bt, M, N, K}; pg8::StaticOrder S; S.init(M, N, (int)gridDim.x, (int)blockIdx.x);
    pg8::gemm_phase<Epi>(wv, lds, g, S, E);
}

enum { J_GU1, J_D1, J_GU2, J_D2, J_IN, J_VS, J_LR, J_QB, J_KN, J_KV, J_OUT, J_COUNT };
DI void wsrc_row(const Params& p, int job, int l, int n, const float*& base, int& stride, int& klo, int& khi) {
    klo = 0;
    switch (job) {
    case J_GU1: case J_GU2: { const int w = n & 255, c = (n >> 8) * 128 + (w & 127); const float* s = (w < 128) ? p.in[job == J_GU1 ? 5 : 32] : p.in[job == J_GU1 ? 6 : 33];
        base = s + (size_t)l * 1024 * DFF + c; stride = DFF; khi = 1024; break; }
    case J_D1: case J_D2: base = p.in[job == J_D1 ? 7 : 34] + (size_t)l * DFF * 1024 + n; stride = 1024; khi = DFF; break;
    case J_IN: { const int c = n < 1664 ? n : n + 128; base = p.in[9] + (size_t)l * 1024 * 2208 + (n < 2080 ? c : 0); stride = 2208; khi = n < 2080 ? 1024 : 0; break; }
    case J_VS: base = p.in[9] + (size_t)l * 1024 * 2208 + 1664 + (n < 128 ? n : 0); stride = 2208; khi = n < 128 ? 1024 : 0; break;
    case J_LR:
        if (n < 512) { const int d = n >> 8, c = n & 255; base = p.in[12] + ((size_t)l * 2 + d) * 64 * 256 + c; stride = 256; klo = 0; khi = 64; }
        else if (n < 1024) { const int d = (n - 512) >> 8, c = n & 255; base = p.in[14] + ((size_t)l * 2 + d) * 64 * 256 + c; stride = 256; klo = 64; khi = 128; }
        else { base = p.in[15] + (size_t)l * 128 * 256 + (n - 1024); stride = 256; klo = 128; khi = 256; }
        break;
    case J_QB: base = p.in[25] + (size_t)l * 256 * 384 + (n < 384 ? n : 0); stride = 384; khi = n < 384 ? 256 : 0; break;
    case J_KN: base = p.in[27] + (size_t)l * 128 * 512 + (n >> 6) * 128 + (n & 63); stride = 512; khi = 128; break;
    case J_KV: base = p.in[27] + (size_t)l * 128 * 512 + (n >> 6) * 128 + 64 + (n & 63); stride = 512; khi = 128; break;
    default: base = p.in[30] + (size_t)l * 1024 * 1024 + n; stride = 1024; khi = 1024; break;
    }
}
DI void job_shape(int job, int& N, int& K, size_t& off) {
    switch (job) {
    case J_GU1: N = 5632; K = 1024; off = W_GU; break;   case J_D1: N = 1024; K = 2816; off = W_D; break;
    case J_GU2: N = 5632; K = 1024; off = W_GU2; break;  case J_D2: N = 1024; K = 2816; off = W_D2; break;
    case J_IN: N = 2304; K = 1024; off = W_IN; break;    case J_VS: N = 256; K = 1024; off = W_VS; break;
    case J_LR: N = 1280; K = 256; off = W_LR; break;     case J_QB: N = 512; K = 256; off = W_QB; break;
    case J_KN: N = 256; K = 256; off = W_KN; break;      case J_KV: N = 256; K = 256; off = W_KV; break;
    default: N = 1024; K = 1024; off = W_OUT; break;
    }
}
DI void phase_weights(int wv, const Params& p, int l, int job_lo, int job_hi, int vgrid, int vblock) {
    bf16_t* W = (bf16_t*)(p.ws + OFF_W);
    const size_t gtid = (size_t)vblock * 512 + tid_(wv), gsz = (size_t)vgrid * 512;
        for (int job = job_lo; job < job_hi; ++job) {
            int N, K; size_t off; job_shape(job, N, K, off);
            bf16_t* dst = W + (size_t)l * W_LAYER + off;
            const size_t ntile = (size_t)(N / 8) * (K / 64);
            const int lane = (int)(gtid & 63), ln = lane >> 3, lk = lane & 7;
            const size_t wstep = gsz >> 6;
            for (size_t tile = gtid >> 6; tile < ntile; tile += 2 * wstep) {
                const size_t tile2 = tile + wstep; const bool has2 = tile2 < ntile;
                const int n = (int)(tile % (N / 8)) * 8 + ln, k0 = (int)(tile / (N / 8)) * 64 + lk * 8;
                const int n2 = has2 ? (int)(tile2 % (N / 8)) * 8 + ln : n, k2 = has2 ? (int)(tile2 / (N / 8)) * 64 + lk * 8 : k0;
                const float *b1, *b2; int st1, st2, lo1, hi1, lo2, hi2;
                wsrc_row(p, job, l, n, b1, st1, lo1, hi1); wsrc_row(p, job, l, n2, b2, st2, lo2, hi2);
                const bool in1 = k0 >= lo1 && k0 < hi1, in2 = k2 >= lo2 && k2 < hi2;
                const float* q1 = b1 + (size_t)(in1 ? k0 - lo1 : 0) * st1; const float* q2 = b2 + (size_t)(in2 ? k2 - lo2 : 0) * st2;
                float v[8], w[8];
#pragma unroll
                for (int j = 0; j < 8; ++j) { v[j] = q1[(size_t)j * st1]; w[j] = q2[(size_t)j * st2]; }
#pragma unroll
                for (int j = 0; j < 8; ++j) { v[j] = in1 ? v[j] : 0.f; w[j] = in2 ? w[j] : 0.f; }
                u32x4 pk = {pack2(v[0], v[1]), pack2(v[2], v[3]), pack2(v[4], v[5]), pack2(v[6], v[7])};
                *(u32x4*)(dst + (size_t)n * K + k0) = pk;
                if (has2) { u32x4 pk2 = {pack2(w[0], w[1]), pack2(w[2], w[3]), pack2(w[4], w[5]), pack2(w[6], w[7])}; *(u32x4*)(dst + (size_t)n2 * K + k2) = pk2; }
            }
        }
}

template <int MODE> DI void phase_norm(int wv, const Params& p, const float* g1, const float* gf, bool last) {
    float* H = (float*)(p.ws + OFF_H); bf16_t* XN = (bf16_t*)((unsigned char*)p.out + O_XN);
    const int tid = tid_(wv), lane = tid & 63, gw = blockIdx.x * 8 + (tid >> 6), nw = gridDim.x * 8;
    f32x4 gg[4], gfv[4];
#pragma unroll
    for (int q = 0; q < 4; ++q) { gg[q] = *(const f32x4*)(g1 + 4 * lane + 256 * q); if (MODE == 2) gfv[q] = *(const f32x4*)(gf + 4 * lane + 256 * q); }
    auto ld_row = [&](int row, f32x4 (&x)[4]) {
        if (MODE == 0) {
            const int s = row_seq(row), t = row - seq_start(s);
            const float* src = nullptr;
            if (row < MTOK) src = t < 16 ? p.in[2] + (size_t)t * D : (s == 0 ? p.in[0] + (size_t)(t - 16) * D : p.in[1] + ((size_t)(s - 1) * 2048 + (t - 16)) * D);
#pragma unroll
            for (int q = 0; q < 4; ++q) x[q] = src ? *(const f32x4*)(src + 4 * lane + 256 * q) : (f32x4){0.f, 0.f, 0.f, 0.f};
        } else {
#pragma unroll
            for (int q = 0; q < 4; ++q) x[q] = *(const f32x4*)(H + (size_t)row * D + 4 * lane + 256 * q);
        }
    };
    f32x4 xn[4];
    if (gw < MPAD) ld_row(gw, xn);
    for (int row = gw; row < MPAD; row += nw) {
        f32x4 x[4];
#pragma unroll
        for (int q = 0; q < 4; ++q) x[q] = xn[q];
        if (row + nw < MPAD) ld_row(row + nw, xn);
        const int s = row_seq(row), t = row - seq_start(s);
        if (MODE == 0) {
#pragma unroll
            for (int q = 0; q < 4; ++q) *(f32x4*)(H + (size_t)row * D + 4 * lane + 256 * q) = x[q];
        }
        float ss = 0.f;
#pragma unroll
        for (int q = 0; q < 4; ++q) ss += x[q][0] * x[q][0] + x[q][1] * x[q][1] + x[q][2] * x[q][2] + x[q][3] * x[q][3];
        ss = xsum_<64>(ss, lane);
        float rs = __builtin_amdgcn_rsqf(ss * (1.f / D) + EPS);
        if (MODE == 2) {
            float ss2 = 0.f;
#pragma unroll
            for (int q = 0; q < 4; ++q) { x[q] = x[q] * rs * gfv[q]; ss2 += x[q][0] * x[q][0] + x[q][1] * x[q][1] + x[q][2] * x[q][2] + x[q][3] * x[q][3]; }
            if (last) {
                if (row < MTOK && t >= 16) {
                    float* o = p.out + ((s == 0 ? (size_t)(t - 16) : (size_t)16384 + (size_t)(s - 1) * 2048 + (t - 16))) * D;
#pragma unroll
                    for (int q = 0; q < 4; ++q) *(f32x4*)(o + 4 * lane + 256 * q) = x[q];
                }
                continue;
            }
#pragma unroll
            for (int q = 0; q < 4; ++q) *(f32x4*)(H + (size_t)row * D + 4 * lane + 256 * q) = x[q];
            ss2 = xsum_<64>(ss2, lane);
            rs = __builtin_amdgcn_rsqf(ss2 * (1.f / D) + EPS);
        }
#pragma unroll
        for (int q = 0; q < 4; ++q) { const f32x4 y = x[q] * rs * gg[q]; u32x2 pk = {pack2(y[0], y[1]), pack2(y[2], y[3])}; *(u32x2*)(XN + (size_t)row * D + 4 * lane + 256 * q) = pk; }
    }
}

DI void phase_prep1(int wv, const Params& p, int l) {
    const bf16_t* P = (const bf16_t*)(p.ws + R_P);
    bf16_t* RR = (bf16_t*)(p.ws + R_RR); bf16_t* KK = (bf16_t*)(p.ws + R_KK); bf16_t* VV = (bf16_t*)(p.ws + R_VV);
    unsigned char* ob = (unsigned char*)p.out;
    bf16_t* QS = (bf16_t*)(ob + O_QS); bf16_t* KS = (bf16_t*)(ob + O_KS); bf16_t* ASM = (bf16_t*)(ob + O_ASM); bf16_t* QA = (bf16_t*)(ob + O_QA); bf16_t* KVA = (bf16_t*)(ob + O_KVA);
    float* INV = (float*)(ob + O_INV); float* BON = (float*)(ob + O_BON); bf16_t* KR = (bf16_t*)(ob + O_KR);
    const int tid = tid_(wv), lane = tid & 63, gw = blockIdx.x * 8 + (tid >> 6), nw = gridDim.x * 8;
    const float* mu = p.in[10] + (size_t)l * 1024;
    const int hd = lane >> 4;
    f32x4 mu_r = *(const f32x4*)(mu + 4 * lane), mu_k = *(const f32x4*)(mu + 256 + 4 * lane), mu_v = *(const f32x4*)(mu + 512 + 4 * lane);
    const float mu_w = mu[768 + lane], mu_a = mu[832 + lane], mu_g0 = mu[896 + 2 * lane], mu_g1 = mu[897 + 2 * lane];
    const f32x4 kk4 = *(const f32x4*)(p.in[16] + (size_t)l * 256 + 4 * lane), rk4 = *(const f32x4*)(p.in[18] + (size_t)l * 256 + 4 * lane);
    const float* qn = p.in[21] + (size_t)l * 64; const float* kn = p.in[22] + (size_t)l * 64;
    float qg[8];
#pragma unroll
    for (int e = 0; e < 8; ++e) qg[e] = qn[(8 * lane + e) & 63] * (0.125f * LOG2E);
    const float kg0 = kn[(2 * lane) & 63], kg1 = kn[(2 * lane + 1) & 63];
    const f32x4 qag = *(const f32x4*)(p.in[24] + (size_t)l * 256 + 4 * lane);
    const float kvg0 = p.in[26][(size_t)l * 128 + 2 * lane], kvg1 = p.in[26][(size_t)l * 128 + 2 * lane + 1];
    struct Raw { u32x2 c0, a0, b0, c1, a1, b1, c2, a2, b2, q2; u32x4 q4; unsigned gc, ga, gb, k2, kv, kr; bf16_t wc, wp, wn, ac, ap, an; };
    auto load_raw = [&](int row, Raw& R) {
        const int s = row_seq(row), t = row - seq_start(s), T = seq_len(s);
        const bf16_t* pc = P + (size_t)row * PLD;
        const bf16_t* pp = t > 0 ? pc - PLD : pc; const bf16_t* pn = t < T - 1 ? pc + PLD : pc;
        R.c0 = *(const u32x2*)(pc + 4 * lane); R.a0 = *(const u32x2*)(pp + 4 * lane); R.b0 = *(const u32x2*)(pn + 4 * lane);
        R.c1 = *(const u32x2*)(pc + 256 + 4 * lane); R.a1 = *(const u32x2*)(pp + 256 + 4 * lane); R.b1 = *(const u32x2*)(pn + 256 + 4 * lane);
        R.c2 = *(const u32x2*)(pc + 512 + 4 * lane); R.a2 = *(const u32x2*)(pp + 512 + 4 * lane); R.b2 = *(const u32x2*)(pn + 512 + 4 * lane);
        R.wc = pc[768 + lane]; R.wp = pp[768 + lane]; R.wn = pn[768 + lane]; R.ac = pc[832 + lane]; R.ap = pp[832 + lane]; R.an = pn[832 + lane];
        R.gc = *(const unsigned*)(pc + 896 + 2 * lane); R.ga = *(const unsigned*)(pp + 896 + 2 * lane); R.gb = *(const unsigned*)(pn + 896 + 2 * lane);
        R.q4 = *(const u32x4*)(pc + 1024 + 8 * lane); R.k2 = *(const unsigned*)(pc + 1536 + 2 * lane);
        R.q2 = *(const u32x2*)(pc + 1664 + 4 * lane); R.kv = *(const unsigned*)(pc + 1920 + 2 * lane);
        R.kr = *(const unsigned*)(pc + 2048 + 2 * (lane & 15));
    };
    Raw cur, nxt;
    if (gw < MTOK) load_raw(gw, cur);
    for (int row = gw; row < MTOK; row += nw) {
        if (row + nw < MTOK) load_raw(row + nw, nxt);
        const int s = row_seq(row), t = row - seq_start(s), T = seq_len(s);
        const float hp = t > 0 ? 0.5f : 0.f, hn = t < T - 1 ? 0.5f : 0.f;
        float r[4], k[4], v[4];
        {
            const u32x2 c0 = cur.c0, a0 = cur.a0, b0 = cur.b0, c1 = cur.c1, a1 = cur.a1, b1 = cur.b1, c2 = cur.c2, a2 = cur.a2, b2 = cur.b2;
#define MIX4(dst, c, a, b, m) do { float x0 = lo_bf(c[0]), x1 = hi_bf(c[0]), x2 = lo_bf(c[1]), x3 = hi_bf(c[1]); \
            dst[0] = x0 + m[0] * (hp * lo_bf(a[0]) + hn * lo_bf(b[0]) - x0); dst[1] = x1 + m[1] * (hp * hi_bf(a[0]) + hn * hi_bf(b[0]) - x1); \
            dst[2] = x2 + m[2] * (hp * lo_bf(a[1]) + hn * lo_bf(b[1]) - x2); dst[3] = x3 + m[3] * (hp * hi_bf(a[1]) + hn * hi_bf(b[1]) - x3); } while (0)
            MIX4(r, c0, a0, b0, mu_r); MIX4(k, c1, a1, b1, mu_k); MIX4(v, c2, a2, b2, mu_v);
#undef MIX4
        }
        float ssk = 0.f, bon = 0.f;
#pragma unroll
        for (int e = 0; e < 4; ++e) { const float q = k[e] * kk4[e]; ssk += q * q; bon += r[e] * k[e] * rk4[e]; }
        ssk = xsum_<16>(ssk, lane); bon = xsum_<16>(bon, lane);
        const float inv = 1.f / fmaxf(sqrtf(ssk), 1e-12f);
        if ((lane & 15) == 0) { INV[(size_t)row * 4 + hd] = inv; BON[(size_t)row * 4 + hd] = bon; }
        { u32x2 pk = {pack2(r[0], r[1]), pack2(r[2], r[3])}; *(u32x2*)(RR + (size_t)row * 256 + 4 * lane) = pk; }
        { u32x2 pk = {pack2(k[0], k[1]), pack2(k[2], k[3])}; *(u32x2*)(KK + (size_t)row * 256 + 4 * lane) = pk; }
        { u32x2 pk = {pack2(v[0], v[1]), pack2(v[2], v[3])}; *(u32x2*)(VV + (size_t)row * 256 + 4 * lane) = pk; }
        {
            float x = bf2f(cur.wc); x = x + mu_w * (hp * bf2f(cur.wp) + hn * bf2f(cur.wn) - x);
            const float e2 = fexp2(2.f * LOG2E * x); const float th = 1.f - 2.f * frcp(e2 + 1.f);
            ASM[(size_t)row * 256 + lane] = f2bf(th);
            float y = bf2f(cur.ac); y = y + mu_a * (hp * bf2f(cur.ap) + hn * bf2f(cur.an) - y);
            ASM[(size_t)row * 256 + 64 + lane] = f2bf(y);
            const unsigned gc = cur.gc, ga = cur.ga, gb = cur.gb;
            float g0 = lo_bf(gc), g1 = hi_bf(gc);
            g0 = g0 + mu_g0 * (hp * lo_bf(ga) + hn * lo_bf(gb) - g0); g1 = g1 + mu_g1 * (hp * hi_bf(ga) + hn * hi_bf(gb) - g1);
            *(unsigned*)(ASM + (size_t)row * 256 + 128 + 2 * lane) = pack2(sigmoidf_(g0), sigmoidf_(g1));
        }
        {
            const u32x4 q4 = cur.q4;
            float q[8] = {lo_bf(q4[0]), hi_bf(q4[0]), lo_bf(q4[1]), hi_bf(q4[1]), lo_bf(q4[2]), hi_bf(q4[2]), lo_bf(q4[3]), hi_bf(q4[3])};
            float ss = 0.f;
#pragma unroll
            for (int e = 0; e < 8; ++e) ss += q[e] * q[e];
            ss = xsum_<8>(ss, lane);
            const float rs = __builtin_amdgcn_rsqf(ss * (1.f / 64) + EPS);
            u32x4 o;
#pragma unroll
            for (int e = 0; e < 4; ++e) o[e] = pack2(q[2 * e] * rs * qg[2 * e], q[2 * e + 1] * rs * qg[2 * e + 1]);
            *(u32x4*)(QS + (size_t)row * 512 + 8 * lane) = o;
            const unsigned k2 = cur.k2;
            const float k0 = lo_bf(k2), k1 = hi_bf(k2);
            float sk = xsum_<32>(k0 * k0 + k1 * k1, lane);
            const float rk = __builtin_amdgcn_rsqf(sk * (1.f / 64) + EPS);
            *(unsigned*)(KS + (size_t)row * 128 + 2 * lane) = pack2(k0 * rk * kg0, k1 * rk * kg1);
        }
        {
            const u32x2 q2 = cur.q2;
            const float q0 = lo_bf(q2[0]), q1 = hi_bf(q2[0]), q2f = lo_bf(q2[1]), q3 = hi_bf(q2[1]);
            const float ss = xsum_<64>(q0 * q0 + q1 * q1 + q2f * q2f + q3 * q3, lane);
            const float rs = __builtin_amdgcn_rsqf(ss * (1.f / 256) + EPS);
            u32x2 o = {pack2(q0 * rs * qag[0], q1 * rs * qag[1]), pack2(q2f * rs * qag[2], q3 * rs * qag[3])};
            *(u32x2*)(QA + (size_t)row * 256 + 4 * lane) = o;
            const unsigned kv = cur.kv;
            const float a = lo_bf(kv), b = hi_bf(kv);
            const float s2 = xsum_<64>(a * a + b * b, lane);
            const float r2 = __builtin_amdgcn_rsqf(s2 * (1.f / 128) + EPS);
            *(unsigned*)(KVA + (size_t)row * 256 + 2 * lane) = pack2(a * r2 * kvg0, b * r2 * kvg1);
            *(unsigned*)(KVA + (size_t)row * 256 + 128 + 2 * lane) = 0u;
            if (lane < 16) *(unsigned*)(KR + (size_t)row * 32 + 2 * lane) = cur.kr;
        }
        cur = nxt;
    }
    for (int row = MTOK + gw; row < MPAD; row += nw) {
        *(u32x2*)(ASM + (size_t)row * 256 + 4 * lane) = (u32x2){0u, 0u};
        *(u32x2*)(QA + (size_t)row * 256 + 4 * lane) = (u32x2){0u, 0u};
        *(u32x2*)(KVA + (size_t)row * 256 + 4 * lane) = (u32x2){0u, 0u};
    }
}

DI void phase_prep2(int wv, const Params& p, int l) {
    bf16_t* QM = (bf16_t*)(p.ws + R_QM); bf16_t* KM = (bf16_t*)(p.ws + R_KM);
    const bf16_t* KR = (const bf16_t*)((unsigned char*)p.out + O_KR);
    const int tid = tid_(wv), lane = tid & 63, gw = blockIdx.x * 8 + (tid >> 6), nw = gridDim.x * 8;
    const int hd = lane >> 4, u = lane & 15;
    const float* qn = p.in[28] + (size_t)l * 96; const float* kn = p.in[29] + (size_t)l * 96;
    const f32x4 qg = *(const f32x4*)(qn + 4 * u), kg = *(const f32x4*)(kn + 4 * u);
    const float qg1 = qn[64 + u], qg2 = qn[80 + u], kg1 = kn[64 + u], kg2 = kn[80 + u];
    const float inv_f = fexp2(-(float)u * (13.287712379549449f / 16.f));
    const float qscale = 0.10206207261596577f * LOG2E;
    struct Raw2 { u32x2 qa, ka; bf16_t q1, q2, k1, k2; };
    auto ld2 = [&](int row, Raw2& R) {
        const bf16_t* q = QM + (size_t)row * 384 + hd * 96; const bf16_t* k = KM + (size_t)row * 384 + hd * 96;
        R.qa = *(const u32x2*)(q + 4 * u); R.q1 = q[64 + u]; R.q2 = q[80 + u];
        R.ka = *(const u32x2*)(k + 4 * u); R.k1 = KR[(size_t)row * 32 + u]; R.k2 = KR[(size_t)row * 32 + 16 + u];
    };
    Raw2 cur, nxt;
    if (gw < MTOK) ld2(gw, cur);
    for (int row = gw; row < MTOK; row += nw) {
        if (row + nw < MTOK) ld2(row + nw, nxt);
        const int s = row_seq(row), t = row - seq_start(s);
        const float ang = (float)t * inv_f;
        const double rev = (double)ang * 0.15915494309189535; const float fr = (float)(rev - __builtin_rint(rev));
        const float sn = __builtin_amdgcn_sinf(fr), cs = __builtin_amdgcn_cosf(fr);
        {
            bf16_t* q = QM + (size_t)row * 384 + hd * 96;
            const u32x2 a = cur.qa;
            float x[4] = {lo_bf(a[0]), hi_bf(a[0]), lo_bf(a[1]), hi_bf(a[1])};
            float x1 = bf2f(cur.q1), x2 = bf2f(cur.q2);
            float ss = x[0] * x[0] + x[1] * x[1] + x[2] * x[2] + x[3] * x[3] + x1 * x1 + x2 * x2;
            ss = xsum_<16>(ss, lane);
            const float rs = __builtin_amdgcn_rsqf(ss * (1.f / 96) + EPS) * qscale;
            u32x2 o = {pack2(x[0] * rs * qg[0], x[1] * rs * qg[1]), pack2(x[2] * rs * qg[2], x[3] * rs * qg[3])};
            x1 *= rs * qg1; x2 *= rs * qg2;
            *(u32x2*)(q + 4 * u) = o; q[64 + u] = f2bf(x1 * cs - x2 * sn); q[80 + u] = f2bf(x1 * sn + x2 * cs);
        }
        {
            bf16_t* k = KM + (size_t)row * 384 + hd * 96;
            const u32x2 a = cur.ka;
            float x[4] = {lo_bf(a[0]), hi_bf(a[0]), lo_bf(a[1]), hi_bf(a[1])};
            float x1 = bf2f(cur.k1), x2 = bf2f(cur.k2);
            float ss = x[0] * x[0] + x[1] * x[1] + x[2] * x[2] + x[3] * x[3] + x1 * x1 + x2 * x2;
            ss = xsum_<16>(ss, lane);
            const float rs = __builtin_amdgcn_rsqf(ss * (1.f / 96) + EPS);
            u32x2 o = {pack2(x[0] * rs * kg[0], x[1] * rs * kg[1]), pack2(x[2] * rs * kg[2], x[3] * rs * kg[3])};
            x1 *= rs * kg1; x2 *= rs * kg2;
            *(u32x2*)(k + 4 * u) = o; k[64 + u] = f2bf(x1 * cs - x2 * sn); k[80 + u] = f2bf(x1 * sn + x2 * cs);
        }
        cur = nxt;
    }
}

DI void chunk_decode(int g, int& seq, int& c) { if (g < NCP) { seq = 0; c = g; } else { seq = 1 + (g - NCP) / NCS; c = (g - NCP) % NCS; } }
DI void chunk_range(int c, int& t0, int& t1) { if (c == 0) { t0 = 0; t1 = 16; } else { t0 = 16 + 128 * (c - 1); t1 = t0 + 128; } }
DI float dpp_add(float x, const int ctrl_sel) {
    const int xi = __builtin_bit_cast(int, x);
    int yi;
    if (ctrl_sel == 0) yi = __builtin_amdgcn_update_dpp(0, xi, 0xB1, 0xf, 0xf, true);
    else if (ctrl_sel == 1) yi = __builtin_amdgcn_update_dpp(0, xi, 0x4E, 0xf, 0xf, true);
    else yi = __builtin_amdgcn_update_dpp(0, xi, 0x141, 0xf, 0xf, true);
    return x + __builtin_bit_cast(float, yi);
}
DI float allsum4(float x) { x = dpp_add(x, 0); x = dpp_add(x, 1); return x; }
template <int DIR> DI void scan_item(const Params& p, int l, LAS float* L, LAS float* CL, int item, int lane) {
    const bf16_t* RR = (const bf16_t*)(p.ws + R_RR); const bf16_t* KK = (const bf16_t*)(p.ws + R_KK); const bf16_t* VV = (const bf16_t*)(p.ws + R_VV);
    const bf16_t* SW = (const bf16_t*)(p.ws + R_SW) + (size_t)DIR * MPAD * 256; const bf16_t* AA = (const bf16_t*)(p.ws + R_AA) + (size_t)DIR * MPAD * 256;
    unsigned char* ob = (unsigned char*)p.out;
    const float* INV = (const float*)(ob + O_INV);
    bf16_t* YL = (bf16_t*)(ob + O_YL) + (size_t)DIR * MPAD * 256; bf16_t* ZZ = (bf16_t*)(p.ws + R_Z) + (size_t)DIR * MPAD * 256; bf16_t* UU = (bf16_t*)(ob + O_U); bf16_t* PT = (bf16_t*)(ob + O_PT);
    const int g = item >> 3, hd = (item >> 1) & 3;
    int seq, c; chunk_decode(g, seq, c); int t0, t1; chunk_range(c, t0, t1);
    const int base = seq_start(seq), nsub = (t1 - t0) >> 3, ch = hd * 64 + lane;
    const int la = lane >> 2, lb = lane & 3;
    CL[lane] = p.in[16][(size_t)l * 256 + ch]; CL[64 + lane] = p.in[17][(size_t)l * 256 + ch];
    f32x2 SU[4][8], SP[4][8];
#pragma unroll
    for (int ri = 0; ri < 4; ++ri)
#pragma unroll
        for (int cp = 0; cp < 8; ++cp) { SU[ri][cp] = (f32x2){0.f, 0.f}; SP[ri][cp] = (f32x2){(4 * la + ri == 16 * lb + 2 * cp) ? 1.f : 0.f, (4 * la + ri == 16 * lb + 2 * cp + 1) ? 1.f : 0.f}; }
    const int ss = lane >> 3, cg = lane & 7;
#define SCAN_FETCH(sub_) const size_t row_ = (size_t)base + (DIR == 0 ? t0 + 8 * (sub_) + ss : t1 - 1 - 8 * (sub_) - ss); const size_t o_ = row_ * 256 + hd * 64 + 8 * cg; \
        const u32x4 xr = *(const u32x4*)(RR + o_), xk = *(const u32x4*)(KK + o_), xv = *(const u32x4*)(VV + o_), xw = *(const u32x4*)(SW + o_), xa = *(const u32x4*)(AA + o_); const float xi = INV[row_ * 4 + hd]
#define LD4(dst, off_) do { const f32x4 t0_ = *(const LAS f32x4*)(Ls + (off_) + 16 * lb), t1_ = *(const LAS f32x4*)(Ls + (off_) + 16 * lb + 4); \
        dst[0] = (f32x2){t0_[0], t0_[1]}; dst[1] = (f32x2){t0_[2], t0_[3]}; dst[2] = (f32x2){t1_[0], t1_[1]}; dst[3] = (f32x2){t1_[2], t1_[3]}; } while (0)
    for (int sub = 0; sub < nsub; ++sub) {
        const size_t rowb = (size_t)base + (DIR == 0 ? t0 + 8 * sub : t1 - 1 - 8 * sub);
        {
            SCAN_FETCH(sub);
            LAS float* Ls = L + ss * 384 + 8 * cg;
            const f32x4 c0 = *(const LAS f32x4*)(CL + 8 * cg), c1 = *(const LAS f32x4*)(CL + 8 * cg + 4), d0 = *(const LAS f32x4*)(CL + 64 + 8 * cg), d1 = *(const LAS f32x4*)(CL + 64 + 8 * cg + 4);
            f32x4 ow[2], oka[2], okd[2], okk[2], orr[2], ov[2];
#pragma unroll
            for (int e = 0; e < 8; ++e) {
                const float r = (e & 1) ? hi_bf(xr[e >> 1]) : lo_bf(xr[e >> 1]), k = (e & 1) ? hi_bf(xk[e >> 1]) : lo_bf(xk[e >> 1]), v = (e & 1) ? hi_bf(xv[e >> 1]) : lo_bf(xv[e >> 1]);
                const float sw = (e & 1) ? hi_bf(xw[e >> 1]) : lo_bf(xw[e >> 1]), a = (e & 1) ? hi_bf(xa[e >> 1]) : lo_bf(xa[e >> 1]);
                const float k_k = e < 4 ? c0[e & 3] : c1[e & 3], k_a = e < 4 ? d0[e & 3] : d1[e & 3];
                const float kk = k * k_k * xi;
                ow[e >> 2][e & 3] = fexp2(-sw * LOG2E); oka[e >> 2][e & 3] = -kk * a; okd[e >> 2][e & 3] = k * (1.f + (a - 1.f) * k_a); okk[e >> 2][e & 3] = kk; orr[e >> 2][e & 3] = r; ov[e >> 2][e & 3] = v;
            }
            *(LAS f32x4*)(Ls) = ow[0]; *(LAS f32x4*)(Ls + 4) = ow[1]; *(LAS f32x4*)(Ls + 64) = oka[0]; *(LAS f32x4*)(Ls + 68) = oka[1];
            *(LAS f32x4*)(Ls + 128) = okd[0]; *(LAS f32x4*)(Ls + 132) = okd[1]; *(LAS f32x4*)(Ls + 192) = okk[0]; *(LAS f32x4*)(Ls + 196) = okk[1];
            *(LAS f32x4*)(Ls + 256) = orr[0]; *(LAS f32x4*)(Ls + 260) = orr[1]; *(LAS f32x4*)(Ls + 320) = ov[0]; *(LAS f32x4*)(Ls + 324) = ov[1];
        }
        __builtin_amdgcn_fence(__ATOMIC_RELEASE, "wavefront"); __builtin_amdgcn_wave_barrier(); __builtin_amdgcn_fence(__ATOMIC_ACQUIRE, "wavefront");
        bf16_t* py = YL + rowb * 256 + ch; bf16_t* pz = ZZ + rowb * 256 + ch;
#pragma unroll 1
        for (int s = 0; s < 8; ++s) {
            const LAS float* Ls = L + s * 384;
            f32x2 aU[4], aP[4];
#pragma unroll
            for (int hh = 0; hh < 2; ++hh) {
                f32x2 kk_[4]; LD4(kk_, 192 + 8 * hh);
#pragma unroll
                for (int ri = 0; ri < 4; ++ri) {
                    if (hh == 0) { aU[ri] = SU[ri][0] * kk_[0]; aP[ri] = SP[ri][0] * kk_[0]; }
                    else { aU[ri] = __builtin_elementwise_fma(SU[ri][4], kk_[0], aU[ri]); aP[ri] = __builtin_elementwise_fma(SP[ri][4], kk_[0], aP[ri]); }
#pragma unroll
                    for (int c = 1; c < 4; ++c) { aU[ri] = __builtin_elementwise_fma(SU[ri][4 * hh + c], kk_[c], aU[ri]); aP[ri] = __builtin_elementwise_fma(SP[ri][4 * hh + c], kk_[c], aP[ri]); }
                }
            }
            float saU[4], saP[4];
#pragma unroll
            for (int ri = 0; ri < 4; ++ri) { saU[ri] = allsum4(aU[ri][0] + aU[ri][1]); saP[ri] = allsum4(aP[ri][0] + aP[ri][1]); }
            __builtin_amdgcn_sched_barrier(0);
            const f32x4 v4 = *(const LAS f32x4*)(Ls + 320 + 4 * la);
            f32x2 bU[4], bP[4];
#pragma unroll
            for (int ri = 0; ri < 4; ++ri) { bU[ri] = (f32x2){0.f, 0.f}; bP[ri] = (f32x2){0.f, 0.f}; }
#pragma unroll
            for (int hh = 0; hh < 2; ++hh) {
                f32x2 wv_[4], ka_[4], kd_[4], r_[4];
                LD4(wv_, 8 * hh); LD4(ka_, 64 + 8 * hh); LD4(kd_, 128 + 8 * hh); LD4(r_, 256 + 8 * hh);
#pragma unroll
                for (int ri = 0; ri < 4; ++ri) {
                    const f32x2 sU2 = {saU[ri], saU[ri]}, sP2 = {saP[ri], saP[ri]}, v2 = {v4[ri], v4[ri]};
#pragma unroll
                    for (int c = 0; c < 4; ++c) {
                        const int cp = 4 * hh + c;
                        f32x2 u = SU[ri][cp] * wv_[c]; u = __builtin_elementwise_fma(sU2, ka_[c], u); u = __builtin_elementwise_fma(v2, kd_[c], u); SU[ri][cp] = u;
                        f32x2 q = SP[ri][cp] * wv_[c]; q = __builtin_elementwise_fma(sP2, ka_[c], q); SP[ri][cp] = q;
                        bU[ri] = __builtin_elementwise_fma(u, r_[c], bU[ri]); bP[ri] = __builtin_elementwise_fma(q, r_[c], bP[ri]);
                    }
                }
                __builtin_amdgcn_sched_barrier(0);
            }
            float oU = 0.f, oP = 0.f;
#pragma unroll
            for (int ri = 0; ri < 4; ++ri) {
                const float yu = allsum4(bU[ri][0] + bU[ri][1]), yp = allsum4(bP[ri][0] + bP[ri][1]);
                oU = lb == ri ? yu : oU; oP = lb == ri ? yp : oP;
            }
            const int so = DIR == 0 ? s : -s;
            py[so * 256] = f2bf(oU); pz[so * 256] = f2bf(oP);
        }
        __builtin_amdgcn_fence(__ATOMIC_RELEASE, "wavefront"); __builtin_amdgcn_wave_barrier(); __builtin_amdgcn_fence(__ATOMIC_ACQUIRE, "wavefront");
    }
#undef SCAN_FETCH
#undef LD4
#pragma unroll
    for (int ri = 0; ri < 4; ++ri) {
        const size_t o = ((size_t)item * 64 + 4 * la + ri) * 64 + 16 * lb;
#pragma unroll
        for (int hh = 0; hh < 2; ++hh) {
            u32x4 x = {pack2(SU[ri][4 * hh][0], SU[ri][4 * hh][1]), pack2(SU[ri][4 * hh + 1][0], SU[ri][4 * hh + 1][1]), pack2(SU[ri][4 * hh + 2][0], SU[ri][4 * hh + 2][1]), pack2(SU[ri][4 * hh + 3][0], SU[ri][4 * hh + 3][1])};
            u32x4 y = {pack2(SP[ri][4 * hh][0], SP[ri][4 * hh][1]), pack2(SP[ri][4 * hh + 1][0], SP[ri][4 * hh + 1][1]), pack2(SP[ri][4 * hh + 2][0], SP[ri][4 * hh + 2][1]), pack2(SP[ri][4 * hh + 3][0], SP[ri][4 * hh + 3][1])};
            *(u32x4*)(UU + o + 8 * hh) = x; *(u32x4*)(PT + o + 8 * hh) = y;
        }
    }
}
DI void phase_scan(int wv, const Params& p, int l, LAS unsigned char* lds) {
    const int tid = tid_(wv), lane = tid & 63, w = tid >> 6, gw = blockIdx.x * 8 + w, nw = gridDim.x * 8;
    LAS float* L = (LAS float*)(lds + w * 12288); LAS float* CL = (LAS float*)(lds + 98304 + w * 512);
    for (int item = gw; item < NCH * 8; item += nw) {
        if (item & 1) scan_item<1>(p, l, L, CL, item, lane); else scan_item<0>(p, l, L, CL, item, lane);
    }
}

DI void propagate_chain(int wv, const Params& p, int chain, LAS unsigned char* lds) {
    unsigned char* ob = (unsigned char*)p.out;
    bf16_t* UU = (bf16_t*)(ob + O_U); const bf16_t* PT = (const bf16_t*)(ob + O_PT);
    const int seq = chain >> 3, hd = (chain >> 1) & 3, dir = chain & 1;
    const int nch = seq == 0 ? NCP : NCS, gbase = seq == 0 ? 0 : NCP + (seq - 1) * NCS;
    const int tid = tid_(wv), i = tid >> 3, jb = tid & 7;
    LAS float* Ssm = (LAS float*)lds;
    LAS float* Psm = (LAS float*)(lds + 17408);
    float S[8];
#pragma unroll
    for (int e = 0; e < 8; ++e) S[e] = 0.f;
    u32x4 u4, p4;
    { const int c = dir == 0 ? 0 : nch - 1; const size_t item = ((size_t)(gbase + c) * 4 + hd) * 2 + dir;
      u4 = *(const u32x4*)(UU + (item * 64 + i) * 64 + 8 * jb); p4 = *(const u32x4*)(PT + (item * 64 + i) * 64 + 8 * jb); }
    for (int step = 0; step < nch; ++step) {
        const int c = dir == 0 ? step : nch - 1 - step; const size_t item = ((size_t)(gbase + c) * 4 + hd) * 2 + dir;
        bf16_t* up = UU + (item * 64 + i) * 64 + 8 * jb;
        __syncthreads();
#pragma unroll
        for (int e = 0; e < 4; ++e) { Psm[i * 64 + 8 * jb + 2 * e] = lo_bf(p4[e]); Psm[i * 64 + 8 * jb + 2 * e + 1] = hi_bf(p4[e]); }
#pragma unroll
        for (int e = 0; e < 8; ++e) Ssm[i * 68 + 8 * jb + e] = S[e];
        { u32x4 so = {pack2(S[0], S[1]), pack2(S[2], S[3]), pack2(S[4], S[5]), pack2(S[6], S[7])}; *(u32x4*)up = so; }
        __syncthreads();
        float acc[8];
#pragma unroll
        for (int e = 0; e < 4; ++e) { acc[2 * e] = lo_bf(u4[e]); acc[2 * e + 1] = hi_bf(u4[e]); }
        if (step + 1 < nch) {
            const int c2 = dir == 0 ? step + 1 : nch - 2 - step; const size_t item2 = ((size_t)(gbase + c2) * 4 + hd) * 2 + dir;
            u4 = *(const u32x4*)(UU + (item2 * 64 + i) * 64 + 8 * jb); p4 = *(const u32x4*)(PT + (item2 * 64 + i) * 64 + 8 * jb);
        }
#pragma unroll 8
        for (int k = 0; k < 64; ++k) {
            const float sv = Ssm[i * 68 + k];
            const f32x4 a = *(const LAS f32x4*)(Psm + k * 64 + 8 * jb), b = *(const LAS f32x4*)(Psm + k * 64 + 8 * jb + 4);
#pragma unroll
            for (int e = 0; e < 4; ++e) { acc[e] += sv * a[e]; acc[4 + e] += sv * b[e]; }
        }
#pragma unroll
        for (int e = 0; e < 8; ++e) S[e] = acc[e];
    }
    __syncthreads();
}

DI void phase_finalize(int wv, const Params& p, int l, LAS unsigned char* lds) {
    unsigned char* ob = (unsigned char*)p.out;
    const bf16_t* YL = (const bf16_t*)(ob + O_YL); const bf16_t* ZZ = (const bf16_t*)(p.ws + R_Z); const bf16_t* UU = (const bf16_t*)(ob + O_U);
    const float* BON = (const float*)(ob + O_BON);
    const bf16_t* VV = (const bf16_t*)(p.ws + R_VV); const bf16_t* G = (const bf16_t*)(p.ws + R_G); bf16_t* MIX = (bf16_t*)(p.ws + R_MIX);
    const int tid = tid_(wv), lane = tid & 63, w = tid >> 6, hd = w >> 1, half = w & 1;
    LAS float* Ssm = (LAS float*)lds;
    const float* lng = p.in[19] + (size_t)l * 256 + hd * 64; const float* lnb = p.in[20] + (size_t)l * 256 + hd * 64;
    for (int g = blockIdx.x; g < NCH; g += gridDim.x) {
        int seq, c; chunk_decode(g, seq, c); int t0, t1; chunk_range(c, t0, t1);
        const int t = t0 + 64 * half + lane; const bool valid = t < t1; const size_t row = (size_t)seq_start(seq) + (valid ? t : t0);
        float y[64];
#pragma unroll
        for (int i = 0; i < 64; ++i) y[i] = 0.f;
        for (int dir = 0; dir < 2; ++dir) {
            __syncthreads();
            {
                const int h2 = tid >> 7, e0 = (tid & 127) * 32;
                const bf16_t* src = UU + ((((size_t)g * 4 + h2) * 2 + dir) * 4096) + e0;
#pragma unroll
                for (int q = 0; q < 4; ++q) { const u32x4 v = *(const u32x4*)(src + 8 * q);
#pragma unroll
                    for (int e = 0; e < 4; ++e) { Ssm[h2 * 4096 + e0 + 8 * q + 2 * e] = lo_bf(v[e]); Ssm[h2 * 4096 + e0 + 8 * q + 2 * e + 1] = hi_bf(v[e]); } }
            }
            __syncthreads();
            const size_t o = ((size_t)dir * MPAD + row) * 256 + hd * 64;
            f32x2 z[32];
            u32x4 zr[8], yr[8];
#pragma unroll
            for (int q = 0; q < 8; ++q) { zr[q] = *(const u32x4*)(ZZ + o + 8 * q); yr[q] = *(const u32x4*)(YL + o + 8 * q); }
            __builtin_amdgcn_sched_barrier(0);
#pragma unroll
            for (int q = 0; q < 8; ++q) { const u32x4 zv = zr[q], yv = yr[q];
#pragma unroll
                for (int e = 0; e < 4; ++e) { z[4 * q + e] = (f32x2){lo_bf(zv[e]), hi_bf(zv[e])}; y[8 * q + 2 * e] += lo_bf(yv[e]); y[8 * q + 2 * e + 1] += hi_bf(yv[e]); } }
            const LAS float* Sh = Ssm + hd * 4096;
#pragma unroll
            for (int i = 0; i < 64; ++i) {
                f32x2 a0 = {0.f, 0.f}, a1 = {0.f, 0.f};
#pragma unroll
                for (int j = 0; j < 16; ++j) { const f32x4 s4 = *(const LAS f32x4*)(Sh + i * 64 + 4 * j);
                    a0 = __builtin_elementwise_fma((f32x2){s4[0], s4[1]}, z[2 * j], a0); a1 = __builtin_elementwise_fma((f32x2){s4[2], s4[3]}, z[2 * j + 1], a1); }
                y[i] += (a0[0] + a0[1]) + (a1[0] + a1[1]);
            }
        }
        if (valid) {
            float mean = 0.f;
#pragma unroll
            for (int i = 0; i < 64; ++i) mean += y[i];
            mean *= (1.f / 64);
            float var = 0.f;
#pragma unroll
            for (int i = 0; i < 64; ++i) { const float d = y[i] - mean; var += d * d; }
            const float rs = __builtin_amdgcn_rsqf(var * (1.f / 64) + 64e-5f);
            const float bon = BON[row * 4 + hd];
            u32x4 vr[8], gr[8];
#pragma unroll
            for (int q = 0; q < 8; ++q) { vr[q] = *(const u32x4*)(VV + row * 256 + hd * 64 + 8 * q); gr[q] = *(const u32x4*)(G + row * 256 + hd * 64 + 8 * q); }
            __builtin_amdgcn_sched_barrier(0);
#pragma unroll
            for (int q = 0; q < 8; ++q) {
                const u32x4 vv = vr[q], gv = gr[q];
                const f32x4 g0 = *(const f32x4*)(lng + 8 * q), g1 = *(const f32x4*)(lng + 8 * q + 4), b0 = *(const f32x4*)(lnb + 8 * q), b1 = *(const f32x4*)(lnb + 8 * q + 4);
                float o8[8];
#pragma unroll
                for (int e = 0; e < 8; ++e) {
                    const float gn = (y[8 * q + e] - mean) * rs * (e < 4 ? g0[e] : g1[e - 4]) + (e < 4 ? b0[e] : b1[e - 4]);
                    const float ve = (e & 1) ? hi_bf(vv[e >> 1]) : lo_bf(vv[e >> 1]), ge = (e & 1) ? hi_bf(gv[e >> 1]) : lo_bf(gv[e >> 1]);
                    o8[e] = (gn + bon * ve) * ge;
                }
                u32x4 pk = {pack2(o8[0], o8[1]), pack2(o8[2], o8[3]), pack2(o8[4], o8[5]), pack2(o8[6], o8[7])};
                *(u32x4*)(MIX + row * 1024 + hd * 64 + 8 * q) = pk;
            }
        }
    }
    __syncthreads();
}

#define MFMA32(a, b, c) __builtin_amdgcn_mfma_f32_32x32x16_bf16((a), (b), (c), 0, 0, 0)
template <int DQK, bool SWA, bool MASK, class KF, class VF>
DI void attn_subtile(const bf16x8 (&qf)[DQK / 16], f32x16& o0, f32x16& o1, float& lsum, int kbase, int h, int qpos, int T, const LAS float* LUT, KF kfrag, VF vfrag) {
    f32x16 s;
#pragma unroll
    for (int i = 0; i < 16; ++i) s[i] = 0.f;
    bf16x8 kf[DQK / 16];
#pragma unroll
    for (int ks = 0; ks < DQK / 16; ++ks) kf[ks] = kfrag(ks);
    const bf16x8 vf00 = vfrag(0, 0), vf10 = vfrag(1, 0), vf01 = vfrag(0, 1), vf11 = vfrag(1, 1);
#pragma unroll
    for (int ks = 0; ks < DQK / 16; ++ks) s = MFMA32(kf[ks], qf[ks], s);
    float pv[16];
    if (SWA) {
        float bias[16];
#pragma unroll
        for (int i = 0; i < 16; ++i) {
            const int rel = kbase + (i & 3) + 8 * (i >> 2) + 4 * h - qpos;
            const int idx = rel < -129 ? -129 : (rel > 129 ? 129 : rel); bias[i] = LUT[idx + 129];
        }
#pragma unroll
        for (int i = 0; i < 16; ++i) {
            const int kpos = kbase + (i & 3) + 8 * (i >> 2) + 4 * h, rel = kpos - qpos;
            const float e = fexp2(s[i] + bias[i]);
            const bool vis = kpos < T && (kpos < 16 || (rel <= 128 && rel >= -128));
            pv[i] = vis ? e : 0.f; lsum += pv[i];
        }
    } else {
#pragma unroll
        for (int i = 0; i < 16; ++i) {
            const float e = fexp2(s[i]);
            if (MASK) { const int kpos = kbase + (i & 3) + 8 * (i >> 2) + 4 * h; pv[i] = kpos < T ? e : 0.f; } else pv[i] = e;
            lsum += pv[i];
        }
    }
#pragma unroll
    for (int s2 = 0; s2 < 2; ++s2) {
        u32x4 pk = {pack2(pv[8 * s2], pv[8 * s2 + 1]), pack2(pv[8 * s2 + 2], pv[8 * s2 + 3]), pack2(pv[8 * s2 + 4], pv[8 * s2 + 5]), pack2(pv[8 * s2 + 6], pv[8 * s2 + 7])};
        const bf16x8 pf = __builtin_bit_cast(bf16x8, pk);
        o0 = MFMA32(s2 == 0 ? vf00 : vf01, pf, o0); o1 = MFMA32(s2 == 0 ? vf10 : vf11, pf, o1);
    }
}
template <int DQK, bool MASK>
DI void attn_tile64(const bf16x8 (&qf)[DQK / 16], f32x16& o0, f32x16& o1, float& lsum, int kbase0, int r, int h, int T, const LAS unsigned char* Ksm, const LAS unsigned char* Vsm) {
    constexpr int KP = DQK * 2 + 16, NKS = DQK / 16;
    bf16x8 ka[2][NKS];
#pragma unroll
    for (int kt = 0; kt < 2; ++kt)
#pragma unroll
        for (int ks = 0; ks < NKS; ++ks) ka[kt][ks] = *(const LAS bf16x8*)(Ksm + (32 * kt + r) * KP + (16 * ks + 8 * h) * 2);
    f32x16 sa[2];
#pragma unroll
    for (int kt = 0; kt < 2; ++kt)
#pragma unroll
        for (int i = 0; i < 16; ++i) sa[kt][i] = 0.f;
#pragma unroll
    for (int ks = 0; ks < NKS; ++ks)
#pragma unroll
        for (int kt = 0; kt < 2; ++kt) sa[kt] = MFMA32(ka[kt][ks], qf[ks], sa[kt]);
    bf16x8 pf[2][2];
    f32x2 ls2 = {0.f, 0.f};
#pragma unroll
    for (int kt = 0; kt < 2; ++kt) {
        float pv[16];
#pragma unroll
        for (int i = 0; i < 16; ++i) {
            const float sv = sa[kt][i];
            if (MASK) { const int kpos = kbase0 + 32 * kt + (i & 3) + 8 * (i >> 2) + 4 * h; const float e = fexp2(sv); pv[i] = kpos < T ? e : 0.f; } else pv[i] = fexp2(sv);
        }
#pragma unroll
        for (int i = 0; i < 16; i += 2) ls2 = ls2 + (f32x2){pv[i], pv[i + 1]};
#pragma unroll
        for (int s2 = 0; s2 < 2; ++s2) {
            u32x4 pk = {pack2(pv[8 * s2], pv[8 * s2 + 1]), pack2(pv[8 * s2 + 2], pv[8 * s2 + 3]), pack2(pv[8 * s2 + 4], pv[8 * s2 + 5]), pack2(pv[8 * s2 + 6], pv[8 * s2 + 7])};
            pf[kt][s2] = __builtin_bit_cast(bf16x8, pk);
        }
    }
    lsum += ls2[0] + ls2[1];
    bf16x8 vf[2][2][2];
#pragma unroll
    for (int kt = 0; kt < 2; ++kt)
#pragma unroll
        for (int s2 = 0; s2 < 2; ++s2)
#pragma unroll
            for (int dt = 0; dt < 2; ++dt) {
                const u32x2 a0 = *(const LAS u32x2*)(Vsm + (32 * dt + r) * 144 + (32 * kt + 16 * s2 + 4 * h) * 2), a1 = *(const LAS u32x2*)(Vsm + (32 * dt + r) * 144 + (32 * kt + 16 * s2 + 8 + 4 * h) * 2);
                u32x4 av = {a0[0], a0[1], a1[0], a1[1]}; vf[kt][s2][dt] = __builtin_bit_cast(bf16x8, av);
            }
#pragma unroll
    for (int kt = 0; kt < 2; ++kt)
#pragma unroll
        for (int s2 = 0; s2 < 2; ++s2) { o0 = MFMA32(vf[kt][s2][0], pf[kt][s2], o0); o1 = MFMA32(vf[kt][s2][1], pf[kt][s2], o1); }
}
DI void attn_lut(LAS float* LUT, int tid, const float* relb, int qhead) {
    if (tid < 259) { const int rel = tid - 129, n = rel < 0 ? -rel : rel; int b;
        if (n < 8) b = n; else { int m = (31 - __builtin_clz((unsigned)(n * n))) - 6; b = 8 + m; if (b > 15) b = 15; }
        if (rel > 0) b += 16;
        LUT[tid] = relb[b * 8 + qhead] * LOG2E; }
}
constexpr int ATT_BUF = 22528, ATT_LUT = 2 * ATT_BUF, ATT_RED = ATT_LUT + 1280;
template <int DQK, bool SWA>
DI void attn_block(int wv, LAS unsigned char* lds, const bf16_t* Q, int ldq, int qoff, const bf16_t* K, int ldk, int koff, const bf16_t* Vt,
                   int base, int T, int q0, bf16_t* O, int ldo, int ooff, const float* relb, int qhead, float sink_add) {
    constexpr int KP = DQK * 2 + 16, CPR = DQK / 8, NKC = 64 * CPR, NKS = DQK / 16, KSZ = 13312;
    const int tid = tid_(wv), lane = tid & 63, w = tid >> 6, r = lane & 31, h = lane >> 5;
    LAS float* LUT = (LAS float*)(lds + ATT_LUT);
    __syncthreads();
    if (SWA) attn_lut(LUT, tid, relb, qhead);
    const int qw0 = q0 + 32 * w, qpos = qw0 + r; const size_t qrow = (size_t)base + qpos;
    bf16x8 qf[NKS];
#pragma unroll
    for (int ks = 0; ks < NKS; ++ks) qf[ks] = *(const bf16x8*)(Q + qrow * ldq + qoff + 16 * ks + 8 * h);
    f32x16 o0, o1;
#pragma unroll
    for (int i = 0; i < 16; ++i) { o0[i] = 0.f; o1[i] = 0.f; }
    float lsum = 0.f;
    const int nt = (T + 63) >> 6;
    int lo = 0, ntl = nt;
    if (SWA) { lo = (q0 - 128) >> 6; if (lo < 1) lo = 1; int hi = (q0 + 255 + 128) >> 6; if (hi > nt - 1) hi = nt - 1; ntl = 1 + (hi >= lo ? hi - lo + 1 : 0); }
    u32x4 kA0, kA1, vA, kB0, kB1, vB;
    kA1 = (u32x4){0u, 0u, 0u, 0u}; kB1 = kA1;
    const int kc0 = tid, kc1 = tid + 512;
    const int kkey0 = kc0 / CPR, kpart0 = kc0 % CPR, kkey1 = kc1 / CPR, kpart1 = kc1 % CPR;
    const int vd = tid >> 3, vpart = tid & 7;
#define ATT_TILE(it_) (SWA ? ((it_) == 0 ? 0 : lo + (it_) - 1) : (it_))
#define ATT_GLOAD(k0_, k1_, v_, tile) do { const size_t rb = (size_t)base + (size_t)(tile) * 64; \
        k0_ = *(const u32x4*)(K + (rb + kkey0) * ldk + koff + kpart0 * 8); \
        if (kc1 < NKC) k1_ = *(const u32x4*)(K + (rb + kkey1) * ldk + koff + kpart1 * 8); \
        v_ = *(const u32x4*)(Vt + (size_t)vd * MPAD + rb + vpart * 8); } while (0)
#define ATT_LWRITE(k0_, k1_, v_, b) do { LAS unsigned char* kb = lds + (b) * ATT_BUF; \
        *(LAS u32x4*)(kb + kkey0 * KP + kpart0 * 16) = k0_; \
        if (kc1 < NKC) *(LAS u32x4*)(kb + kkey1 * KP + kpart1 * 16) = k1_; \
        *(LAS u32x4*)(kb + KSZ + vd * 144 + vpart * 16) = v_; } while (0)
#define ATT_COMPUTE(it_) do { const int tile = ATT_TILE(it_); \
        const LAS unsigned char* Ksm = lds + ((it_) & 1) * ATT_BUF; const LAS unsigned char* Vsm = Ksm + KSZ; \
        if (!SWA) { \
            if (tile * 64 + 64 > T) attn_tile64<DQK, true>(qf, o0, o1, lsum, tile * 64, r, h, T, Ksm, Vsm); \
            else attn_tile64<DQK, false>(qf, o0, o1, lsum, tile * 64, r, h, T, Ksm, Vsm); \
        } else { \
            _Pragma("unroll") for (int kt = 0; kt < 2; ++kt) { \
                const int kbase = tile * 64 + 32 * kt; \
                const bool need = (kbase < 16) || (kbase + 31 >= qw0 - 128 && kbase <= qw0 + 31 + 128); if (!need) continue; \
                auto kfrag = [&](int ks) { return *(const LAS bf16x8*)(Ksm + (32 * kt + r) * KP + (16 * ks + 8 * h) * 2); }; \
                auto vfrag = [&](int dt, int s2) { const u32x2 a0 = *(const LAS u32x2*)(Vsm + (32 * dt + r) * 144 + (32 * kt + 16 * s2 + 4 * h) * 2), a1 = *(const LAS u32x2*)(Vsm + (32 * dt + r) * 144 + (32 * kt + 16 * s2 + 8 + 4 * h) * 2); \
                                               u32x4 av = {a0[0], a0[1], a1[0], a1[1]}; return __builtin_bit_cast(bf16x8, av); }; \
                attn_subtile<DQK, true, true>(qf, o0, o1, lsum, kbase, h, qpos, T, LUT, kfrag, vfrag); \
            } \
        } } while (0)
    ATT_GLOAD(kA0, kA1, vA, ATT_TILE(0)); ATT_LWRITE(kA0, kA1, vA, 0);
    if (ntl > 1) ATT_GLOAD(kB0, kB1, vB, ATT_TILE(1));
    if (ntl > 2) ATT_GLOAD(kA0, kA1, vA, ATT_TILE(2));
    __syncthreads();
    for (int it = 0; it < ntl; it += 2) {
        if (it + 1 < ntl) ATT_LWRITE(kB0, kB1, vB, 1);
        if (it + 3 < ntl) ATT_GLOAD(kB0, kB1, vB, ATT_TILE(it + 3));
        ATT_COMPUTE(it);
        __syncthreads();
        if (it + 1 < ntl) {
            if (it + 2 < ntl) ATT_LWRITE(kA0, kA1, vA, 0);
            if (it + 4 < ntl) ATT_GLOAD(kA0, kA1, vA, ATT_TILE(it + 4));
            ATT_COMPUTE(it + 1);
            __syncthreads();
        }
    }
#undef ATT_COMPUTE
#undef ATT_GLOAD
#undef ATT_LWRITE
#undef ATT_TILE
    lsum += shx(lsum, lane, 32);
    const float il = 1.f / (lsum + sink_add);
    bf16_t* op = O + ((size_t)base + qpos) * ldo + ooff;
#pragma unroll
    for (int g4 = 0; g4 < 4; ++g4) {
        u32x2 a = {pack2(o0[4 * g4] * il, o0[4 * g4 + 1] * il), pack2(o0[4 * g4 + 2] * il, o0[4 * g4 + 3] * il)};
        u32x2 b = {pack2(o1[4 * g4] * il, o1[4 * g4 + 1] * il), pack2(o1[4 * g4 + 2] * il, o1[4 * g4 + 3] * il)};
        *(u32x2*)(op + 8 * g4 + 4 * h) = a; *(u32x2*)(op + 32 + 8 * g4 + 4 * h) = b;
    }
}
template <int DQK, bool SWA>
DI void attn_tail(int wv, LAS unsigned char* lds, const bf16_t* Q, int ldq, int qoff, const bf16_t* K, int ldk, int koff, const bf16_t* Vt,
                  int base, int T, int q0, bf16_t* O, int ldo, int ooff, const float* relb, int qhead, float sink_add) {
    constexpr int NKS = DQK / 16;
    const int tid = tid_(wv), lane = tid & 63, w = tid >> 6, r = lane & 31, h = lane >> 5;
    LAS float* LUT = (LAS float*)(lds + ATT_LUT); LAS float* RED = (LAS float*)(lds + ATT_RED);
    __syncthreads();
    if (SWA) attn_lut(LUT, tid, relb, qhead);
    for (int e = tid; e < 64 * 33; e += 512) RED[e] = 0.f;
    const int qpos = q0 + r; const bool qvalid = qpos < T; const size_t qrow = (size_t)base + (qvalid ? qpos : T - 1);
    bf16x8 qf[NKS];
#pragma unroll
    for (int ks = 0; ks < NKS; ++ks) qf[ks] = *(const bf16x8*)(Q + qrow * ldq + qoff + 16 * ks + 8 * h);
    f32x16 o0, o1;
#pragma unroll
    for (int i = 0; i < 16; ++i) { o0[i] = 0.f; o1[i] = 0.f; }
    float lsum = 0.f;
    const int nt = (T + 63) >> 6;
    int lo = 0, ntl = nt;
    if (SWA) { lo = (q0 - 128) >> 6; if (lo < 1) lo = 1; int hi = nt - 1; ntl = 1 + (hi >= lo ? hi - lo + 1 : 0); }
    __syncthreads();
    for (int it = w; it < ntl; it += 8) {
        const int tile = SWA ? (it == 0 ? 0 : lo + it - 1) : it;
#pragma unroll
        for (int kt = 0; kt < 2; ++kt) {
            const int kbase = tile * 64 + 32 * kt; const size_t rb = (size_t)base + kbase;
            auto kfrag = [&](int ks) { return *(const bf16x8*)(K + (rb + r) * ldk + koff + 16 * ks + 8 * h); };
            auto vfrag = [&](int dt, int s2) { const bf16_t* vp = Vt + (size_t)(32 * dt + r) * MPAD + rb + 16 * s2 + 4 * h; const u32x2 a0 = *(const u32x2*)vp, a1 = *(const u32x2*)(vp + 8);
                                           u32x4 av = {a0[0], a0[1], a1[0], a1[1]}; return __builtin_bit_cast(bf16x8, av); };
            attn_subtile<DQK, SWA, true>(qf, o0, o1, lsum, kbase, h, qpos, T, LUT, kfrag, vfrag);
        }
    }
#pragma unroll
    for (int i = 0; i < 16; ++i) { atomicAdd((float*)(RED + lane * 33 + i), o0[i]); atomicAdd((float*)(RED + lane * 33 + 16 + i), o1[i]); }
    atomicAdd((float*)(RED + lane * 33 + 32), lsum);
    __syncthreads();
    if (w == 0) {
        float l = RED[lane * 33 + 32]; l += shx(l, lane, 32);
        const float il = 1.f / (l + sink_add);
        if (qvalid) {
            bf16_t* op = O + ((size_t)base + qpos) * ldo + ooff;
#pragma unroll
            for (int g4 = 0; g4 < 4; ++g4) {
                const LAS float* a = RED + lane * 33 + 4 * g4; const LAS float* b = RED + lane * 33 + 16 + 4 * g4;
                u32x2 pa = {pack2(a[0] * il, a[1] * il), pack2(a[2] * il, a[3] * il)}, pb = {pack2(b[0] * il, b[1] * il), pack2(b[2] * il, b[3] * il)};
                *(u32x2*)(op + 8 * g4 + 4 * h) = pa; *(u32x2*)(op + 32 + 8 * g4 + 4 * h) = pb;
            }
        }
    }
}

constexpr int N_CHAIN = NSEQ * 8, N_TAIL = NSEQ * 12, N_MLA = 64 * 4 + 32 * 8 * 4, N_SWA = 64 * 8 + 32 * 8 * 8, N_QITEMS = N_CHAIN + N_TAIL + N_MLA + N_SWA;
DI void phase_queue(int wv, const Params& p, int l, LAS unsigned char* lds) {
    unsigned* ctr = (unsigned*)(p.ws + OFF_CTL) + l * 16;
    LAS int* bc = (LAS int*)(lds + 57344);
    unsigned char* ob = (unsigned char*)p.out;
    bf16_t* MIX = (bf16_t*)(p.ws + R_MIX);
    const bf16_t* QM = (const bf16_t*)(p.ws + R_QM); const bf16_t* KM = (const bf16_t*)(p.ws + R_KM); const bf16_t* VTM = (const bf16_t*)(p.ws + R_VTM);
    const bf16_t* QS = (const bf16_t*)(ob + O_QS); const bf16_t* KS = (const bf16_t*)(ob + O_KS); const bf16_t* VTS = (const bf16_t*)(p.ws + R_VTS);
    for (;;) {
        __syncthreads();
        if (tid_(wv) == 0) *bc = (int)atomicAdd(ctr, 1u);
        __syncthreads();
        int it = *bc;
        if (it >= N_QITEMS) break;
        if (it < N_CHAIN) { propagate_chain(wv, p, it, lds); continue; }
        it -= N_CHAIN;
        if (it < N_TAIL) {
            const int seq = it / 12, hh = it % 12, T = seq_len(seq), q0 = T - 16;
            if (hh < 4) attn_tail<96, false>(wv, lds, QM, 384, hh * 96, KM, 384, hh * 96, VTM + (size_t)hh * 64 * MPAD, seq_start(seq), T, q0, MIX, 1024, 768 + hh * 64, nullptr, 0, 0.f);
            else { const int head = hh - 4; attn_tail<64, true>(wv, lds, QS, 512, head * 64, KS, 128, (head >> 2) * 64, VTS + (size_t)(head >> 2) * 64 * MPAD, seq_start(seq), T, q0, MIX, 1024, 256 + head * 64,
                                                               p.in[3], head, fexp2(p.in[23][(size_t)l * 8 + head] * LOG2E)); }
            continue;
        }
        it -= N_TAIL;
        if (it < N_MLA) {
            int seq, head, qb;
            if (it < 256) { seq = 0; head = it & 3; qb = it >> 2; } else { const int m = it - 256; seq = 1 + (m >> 5); head = m & 3; qb = (m >> 2) & 7; }
            attn_block<96, false>(wv, lds, QM, 384, head * 96, KM, 384, head * 96, VTM + (size_t)head * 64 * MPAD, seq_start(seq), seq_len(seq), qb * 256, MIX, 1024, 768 + head * 64, nullptr, 0, 0.f);
            continue;
        }
        it -= N_MLA;
        {
            int seq, head, qb;
            if (it < 512) { seq = 0; head = it & 7; qb = it >> 3; } else { const int m = it - 512; seq = 1 + (m >> 6); head = m & 7; qb = (m >> 3) & 7; }
            attn_block<64, true>(wv, lds, QS, 512, head * 64, KS, 128, (head >> 2) * 64, VTS + (size_t)(head >> 2) * 64 * MPAD, seq_start(seq), seq_len(seq), qb * 256, MIX, 1024, 256 + head * 64,
                                 p.in[3], head, fexp2(p.in[23][(size_t)l * 8 + head] * LOG2E));
        }
    }
}

#define XB_TMO      128
#define XB_XCNT(j)  (256  + 64 * (j))
#define XB_XSUB(j)  (1280 + 64 * (j))
#define XB_XGEN(j)  (2304 + 64 * (j))
#define XB_TOP      3328
#define XB_TOPGEN   3392
#define XB_SPIN_CAP (1u << 18)
DI unsigned xb_ld(unsigned* p)              { return __hip_atomic_load(p, __ATOMIC_RELAXED, __HIP_MEMORY_SCOPE_AGENT); }
DI unsigned xb_add(unsigned* p, unsigned v) { return __hip_atomic_fetch_add(p, v, __ATOMIC_RELAXED, __HIP_MEMORY_SCOPE_AGENT); }
DI unsigned xb_xcc_id() { return (unsigned)__builtin_amdgcn_s_getreg((3 << 11) | 20) & 0xFu; }
#define XB_SPIN(cond, bar) do { unsigned _sp = 0; while (cond) { __builtin_amdgcn_s_sleep(1); \
    if ((++_sp & 255u) == 0u) { if (xb_ld(&(bar)[XB_TMO])) break; if (_sp > XB_SPIN_CAP) { atomicAdd(&(bar)[XB_TMO], 1u); break; } } } } while (0)
struct XcdBarrier { unsigned* bar; unsigned x; volatile LAS unsigned* st; };
DI void xcd_barrier_complete(unsigned* bar, unsigned x, unsigned& nloc, unsigned& nx) {
    const unsigned G = gridDim.x;
    unsigned sum, cnt, mine, sp = 0u;
    for (;;) {
        sum = 0u; cnt = 0u; mine = 0u;
#pragma unroll
        for (unsigned j = 0; j < 16; ++j) { const unsigned c = xb_ld(&bar[XB_XCNT(j)]); sum += c; cnt += (c > 0u) ? 1u : 0u; mine = (j == x) ? c : mine; }
        if (sum == G) break;
        __builtin_amdgcn_s_sleep(1);
        if ((++sp & 255u) == 0u) { if (xb_ld(&bar[XB_TMO])) break; if (sp > XB_SPIN_CAP) { atomicAdd(&bar[XB_TMO], 1u); break; } }
    }
    nloc = mine > 0u ? mine : 1u; nx = cnt > 0u ? cnt : 1u;
}
DI void xcd_barrier(const XcdBarrier& b, int wv) {
    asm volatile("s_waitcnt vmcnt(0)" ::: "memory");
    __syncthreads();
    if (tid_(wv) == 0) {
        unsigned* bar = b.bar;
        __builtin_amdgcn_s_waitcnt(0);
        unsigned nloc = b.st[0], nx = b.st[1];
        if (nloc == 0u) { xcd_barrier_complete(bar, b.x, nloc, nx); b.st[0] = nloc; b.st[1] = nx; }
        const unsigned old = xb_add(&bar[XB_XSUB(b.x)], 1u);
        const unsigned gen = old / nloc;
        if (old + 1u == (gen + 1u) * nloc) {
            __builtin_amdgcn_fence(__ATOMIC_RELEASE, "agent");
            asm volatile("s_waitcnt vmcnt(0)" ::: "memory");
            const unsigned og = xb_add(&bar[XB_TOP], 1u);
            const unsigned tg = og / nx;
            if (og + 1u == (tg + 1u) * nx) xb_add(&bar[XB_TOPGEN], 1u);
            else XB_SPIN(xb_ld(&bar[XB_TOPGEN]) == tg, bar);
            __builtin_amdgcn_fence(__ATOMIC_ACQUIRE, "agent");
            xb_add(&bar[XB_XGEN(b.x)], 1u);
            asm volatile("s_waitcnt vmcnt(0)" ::: "memory");
        } else {
            XB_SPIN(xb_ld(&bar[XB_XGEN(b.x)]) == gen, bar);
            __builtin_amdgcn_fence(__ATOMIC_ACQUIRE, "agent");
            asm volatile("s_waitcnt vmcnt(0)" ::: "memory");
        }
    }
    __syncthreads();
}

template <int l> DI void layer_body(int wv, const Params& p, LAS unsigned char* lds, const XcdBarrier& xb) {
    unsigned char* ob = (unsigned char*)p.out;
    float* H = (float*)(p.ws + OFF_H);
    bf16_t* XN = (bf16_t*)(ob + O_XN);
    bf16_t* ACT = (bf16_t*)(p.ws + R_ACT);
    const bf16_t* W = (const bf16_t*)(p.ws + OFF_W) + (size_t)l * W_LAYER;
    run_gemm(wv, lds, XN, W + W_GU, MPAD, 5632, 1024, EpiSwiglu{ACT});
    xcd_barrier(xb, wv);
    float* SS1 = (float*)(p.ws + OFF_SS1); float* SS2 = (float*)(p.ws + OFF_SS2);
    run_gemm(wv, lds, ACT, W + W_D, MPAD, 1024, 2816, EpiRes{H, 0.5f});
    if (l == 0 && (int)blockIdx.x >= 12) phase_weights(wv, p, 0, J_GU2, J_COUNT, (int)gridDim.x - 12, (int)blockIdx.x - 12);
    xcd_barrier(xb, wv);
    phase_norm<1>(wv, p, p.in[8] + (size_t)l * D, nullptr, false);
    xcd_barrier(xb, wv);
    run_gemm(wv, lds, XN, W + W_IN, MPAD, 2304, 1024, EpiSt<0>{(bf16_t*)(p.ws + R_P), (size_t)PLD, 2304});
    run_gemm(wv, lds, W + W_VS, XN, 256, MPAD, 1024, EpiSt<0>{(bf16_t*)(p.ws + R_VTS), (size_t)MPAD, MPAD});
    xcd_barrier(xb, wv);
    phase_prep1(wv, p, l);
    xcd_barrier(xb, wv);
    run_gemm(wv, lds, (const bf16_t*)(ob + O_ASM), W + W_LR, MPAD, 1280, 256,
             EpiLr{(bf16_t*)(p.ws + R_SW), (bf16_t*)(p.ws + R_AA), (bf16_t*)(p.ws + R_G), p.in[11] + (size_t)l * 512, p.in[13] + (size_t)l * 512});
    run_gemm(wv, lds, (const bf16_t*)(ob + O_QA), W + W_QB, MPAD, 512, 256, EpiSt<0>{(bf16_t*)(p.ws + R_QM), (size_t)384, 384});
    run_gemm(wv, lds, (const bf16_t*)(ob + O_KVA), W + W_KN, MPAD, 256, 256, EpiSt<1>{(bf16_t*)(p.ws + R_KM), (size_t)384, 256});
    run_gemm(wv, lds, W + W_KV, (const bf16_t*)(ob + O_KVA), 256, MPAD, 256, EpiSt<0>{(bf16_t*)(p.ws + R_VTM), (size_t)MPAD, MPAD});
    xcd_barrier(xb, wv);
    phase_prep2(wv, p, l);
    phase_scan(wv, p, l, lds);
    xcd_barrier(xb, wv);
    phase_queue(wv, p, l, lds);
    xcd_barrier(xb, wv);
    phase_finalize(wv, p, l, lds);
    xcd_barrier(xb, wv);
    run_gemm(wv, lds, (const bf16_t*)(p.ws + R_MIX), W + W_OUT, MPAD, 1024, 1024, EpiRes{H, 1.0f});
    if (l == 0 && (int)blockIdx.x >= 12) phase_weights(wv, p, 1, J_GU1, J_GU2, (int)gridDim.x - 12, (int)blockIdx.x - 12);
    xcd_barrier(xb, wv);
    phase_norm<1>(wv, p, p.in[31] + (size_t)l * D, nullptr, false);
    xcd_barrier(xb, wv);
    run_gemm(wv, lds, XN, W + W_GU2, MPAD, 5632, 1024, EpiSwiglu{ACT});
    xcd_barrier(xb, wv);
    run_gemm(wv, lds, ACT, W + W_D2, MPAD, 1024, 2816, EpiRes{H, 0.5f});
    if (l == 0 && (int)blockIdx.x >= 12) phase_weights(wv, p, 1, J_GU2, J_COUNT, (int)gridDim.x - 12, (int)blockIdx.x - 12);
    xcd_barrier(xb, wv);
    phase_norm<2>(wv, p, p.in[4] + (size_t)(l < 1 ? l + 1 : 0) * D, p.in[35] + (size_t)l * D, l == 1);
}
__global__ void __launch_bounds__(512, 2) hybrid_fwd(Params p) {
    extern __shared__ __attribute__((aligned(16))) unsigned char shm[];
    LAS unsigned char* lds = (LAS unsigned char*)shm;
    cg::grid_group grid = cg::this_grid();
    const int wv = __builtin_amdgcn_readfirstlane((int)threadIdx.x >> 6);
    volatile LAS unsigned* st = (volatile LAS unsigned*)(lds + 131072 + 64);
    if (threadIdx.x == 0) { st[0] = 0u; st[1] = 0u; }
    __syncthreads();
    XcdBarrier xb; xb.bar = (unsigned*)(p.ws + OFF_CTL + 8192); xb.x = xb_xcc_id(); xb.st = st;
    if (threadIdx.x == 0) (void)xb_add(&xb.bar[XB_XCNT(xb.x)], 1u);
    phase_weights(wv, p, 0, J_GU1, J_GU2, (int)gridDim.x, (int)blockIdx.x);
    phase_norm<0>(wv, p, p.in[4], nullptr, false);
    grid.sync();
    layer_body<0>(wv, p, lds, xb);
    xcd_barrier(xb, wv);
    layer_body<1>(wv, p, lds, xb);
}

extern "C" void kernel_launch(void* const* d_in, const int* in_sizes, int n_in, void* d_out, int out_size, void* d_ws, size_t ws_size, hipStream_t stream) {
    static int grid_blocks = 0;
    if (!grid_blocks) {
        int dev = 0, cus = 0, per_cu = 0;
        hipGetDevice(&dev);
        hipDeviceGetAttribute(&cus, hipDeviceAttributeMultiprocessorCount, dev);
        if (hipFuncSetAttribute((const void*)hybrid_fwd, hipFuncAttributeMaxDynamicSharedMemorySize, LDS_BYTES) != hipSuccess) fprintf(stderr, "hipFuncSetAttribute failed\n");
        hipOccupancyMaxActiveBlocksPerMultiprocessor(&per_cu, (const void*)hybrid_fwd, 512, LDS_BYTES);
        if (per_cu < 1) per_cu = 1;
        grid_blocks = cus * per_cu;
        if (grid_blocks > 256) grid_blocks = 256;
        if (ws_size < WS_NEED || n_in != 36) fprintf(stderr, "kernel_launch: unexpected ws_size %zu (need %zu) or n_in %d\n", ws_size, (size_t)WS_NEED, n_in);
    }
    Params p{};
    for (int i = 0; i < 36; ++i) p.in[i] = (const float*)d_in[i];
    p.out = (float*)d_out; p.ws = (unsigned char*)d_ws;
    hipMemsetAsync((unsigned char*)d_ws + OFF_CTL, 0, CTL_BYTES, stream);
    void* args[] = {&p};
    hipError_t e = hipLaunchCooperativeKernel((const void*)hybrid_fwd, dim3(grid_blocks), dim3(512), args, LDS_BYTES, stream);
    if (e != hipSuccess) fprintf(stderr, "cooperative launch failed: %s (grid %d)\n", hipGetErrorString(e), grid_blocks);
}
```
